# Optimizing an MI355X kernel written in HIP

```python
import math
import jax, jax.numpy as jnp
from jax import lax
import numpy as np

D_MODEL = 1024
BATCH = 8
SEQ = 2048
DEPTH = 1

GDN_HEAD_DIM = 128
GDN_HEADS = D_MODEL // GDN_HEAD_DIM
GDN_WIDTH = GDN_HEADS * GDN_HEAD_DIM
CONV_K = 4
CHUNK = 64
DIFF_HEAD_DIM = 64
DIFF_V_DIM = 2 * DIFF_HEAD_DIM
DIFF_HEADS = D_MODEL // DIFF_V_DIM
DIFF_QK_WIDTH = DIFF_HEADS * 2 * DIFF_HEAD_DIM
DIFF_WIDTH = DIFF_HEADS * DIFF_V_DIM
Q_BLOCK = 128
D_FF = -(-8 * D_MODEL // (3 * 256)) * 256
EPS = 1e-6

SPLIT_SIZES = (GDN_WIDTH, GDN_WIDTH, GDN_WIDTH, GDN_WIDTH, GDN_HEADS, GDN_HEADS,
               DIFF_QK_WIDTH, DIFF_QK_WIDTH, DIFF_WIDTH, D_MODEL, D_MODEL)
D_IN = sum(SPLIT_SIZES)
SPLIT_POINTS = tuple(sum(SPLIT_SIZES[:i + 1]) for i in range(len(SPLIT_SIZES) - 1))

kernel_name = "hybrid_gdn_diffattn_gated_merge_swiglu"


def rms_norm(x, w):
    xf = x.astype(jnp.float32)
    y = xf * lax.rsqrt(jnp.mean(xf * xf, axis=-1, keepdims=True) + EPS)
    return (y * w.astype(jnp.float32)).astype(x.dtype)


def l2_norm(x):
    return x * lax.rsqrt(jnp.sum(x * x, axis=-1, keepdims=True) + EPS)


def causal_depthwise_conv(x, w):
    return lax.conv_general_dilated(
        x, w[:, None, :], window_strides=(1,), padding=[(w.shape[0] - 1, 0)],
        dimension_numbers=('NWC', 'WIO', 'NWC'), feature_group_count=x.shape[-1])


def chunk_gated_delta_rule(q, k, v, g, beta):
    B, S, H, DK = q.shape
    DV = v.shape[-1]
    N = S // CHUNK

    def to_chunks(t):
        t = jnp.moveaxis(t, 2, 1)
        return t.reshape(t.shape[:2] + (N, CHUNK) + t.shape[3:])

    q, k, v, g, beta = (to_chunks(t) for t in (q * DK ** -0.5, k, v, g, beta))
    gc = jnp.cumsum(g, axis=-1)
    idx = jnp.arange(CHUNK)
    causal = idx[:, None] >= idx[None, :]
    strict = idx[:, None] > idx[None, :]
    decay = jnp.exp(jnp.where(causal, gc[..., :, None] - gc[..., None, :], -jnp.inf))
    kb = k * beta[..., None]
    lower = jnp.where(strict, jnp.einsum('bhnid,bhnjd->bhnij', kb, k) * decay, 0.0)
    eye = jnp.eye(CHUNK, dtype=q.dtype)
    t_inv = lax.linalg.triangular_solve(eye + lower, jnp.broadcast_to(eye, lower.shape),
                                        left_side=True, lower=True)
    u = t_inv @ (v * beta[..., None])
    w = t_inv @ (kb * jnp.exp(gc)[..., None])
    a_qk = jnp.einsum('bhnid,bhnjd->bhnij', q, k) * decay
    q_dec = q * jnp.exp(gc)[..., None]
    g_last = gc[..., -1]
    k_dec = k * jnp.exp(g_last[..., None] - gc)[..., None]

    def step(state, xs):
        u_n, w_n, qd_n, aqk_n, kd_n, gl_n = xs
        v_new = u_n - w_n @ state
        o_n = qd_n @ state + aqk_n @ v_new
        state = state * jnp.exp(gl_n)[..., None, None] + jnp.swapaxes(kd_n, -1, -2) @ v_new
        return state, o_n

    xs = tuple(jnp.moveaxis(t, 2, 0) for t in (u, w, q_dec, a_qk, k_dec, g_last))
    s0 = jnp.zeros((B, H, DK, DV), q.dtype)
    _, o = lax.scan(step, s0, xs)
    o = jnp.moveaxis(o, 0, 2).reshape(B, H, S, DV)
    return jnp.moveaxis(o, 1, 2)


def gated_delta_net(q, k, v, z, a, b, conv_w, a_log, dt_bias, norm_w):
    B, S, _ = q.shape
    f32 = jnp.float32
    qkv = jnp.concatenate([q, k, v], axis=-1).astype(f32)
    qkv = jax.nn.silu(causal_depthwise_conv(qkv, conv_w.astype(f32)))
    q, k, v = jnp.split(qkv, 3, axis=-1)
    q = l2_norm(q.reshape(B, S, GDN_HEADS, GDN_HEAD_DIM))
    k = l2_norm(k.reshape(B, S, GDN_HEADS, GDN_HEAD_DIM))
    v = v.reshape(B, S, GDN_HEADS, GDN_HEAD_DIM)
    beta = jax.nn.sigmoid(b.astype(f32))
    g = -jnp.exp(a_log.astype(f32)) * jax.nn.softplus(a.astype(f32) + dt_bias.astype(f32))
    o = chunk_gated_delta_rule(q, k, v, g, beta)
    o = rms_norm(o, norm_w) * jax.nn.silu(z.reshape(B, S, GDN_HEADS, GDN_HEAD_DIM).astype(f32))
    return o.reshape(B, S, GDN_WIDTH)


def diff_attention(q, k, v, q_norm_w, k_norm_w, lq1, lk1, lq2, lk2, subln_w, lambda_init):
    B, S, _ = q.shape
    f32 = jnp.float32
    q = rms_norm(q.reshape(B, S, DIFF_HEADS, 2, DIFF_HEAD_DIM), q_norm_w).astype(f32) * DIFF_HEAD_DIM ** -0.5
    k = rms_norm(k.reshape(B, S, DIFF_HEADS, 2, DIFF_HEAD_DIM), k_norm_w).astype(f32)
    v = v.reshape(B, S, DIFF_HEADS, DIFF_V_DIM).astype(f32)
    lam = (jnp.exp(jnp.sum(lq1.astype(f32) * lk1.astype(f32)))
           - jnp.exp(jnp.sum(lq2.astype(f32) * lk2.astype(f32))) + lambda_init)
    outs = []
    for blk in range(S // Q_BLOCK):
        start = blk * Q_BLOCK
        end = start + Q_BLOCK
        s = jnp.einsum('bqhcd,bkhcd->bhcqk', q[:, start:end], k[:, :end])
        qpos = start + jnp.arange(Q_BLOCK)
        kpos = jnp.arange(end)
        s = jnp.where(kpos[None, :] <= qpos[:, None], s, -jnp.inf)
        p = jax.nn.softmax(s, axis=-1)
        attn = p[:, :, 0] - lam * p[:, :, 1]
        outs.append(jnp.einsum('bhqk,bkhd->bqhd', attn, v[:, :end]))
    o = jnp.concatenate(outs, axis=1)
    o = rms_norm(o, subln_w) * (1.0 - lambda_init)
    return o.reshape(B, S, DIFF_WIDTH)


def setup_inputs(seed: int = 0) -> dict:
    key = jax.random.key(seed)
    ks = jax.random.split(key, 20)
    nrm = jax.random.normal
    f32 = jnp.float32
    dt = jnp.exp(jax.random.uniform(ks[5], (DEPTH, GDN_HEADS), f32, math.log(1e-3), math.log(1e-1)))
    return {
        "x": nrm(ks[0], (BATCH, SEQ, D_MODEL), f32),
        "norm1_w": 1.0 + 0.02 * nrm(ks[1], (DEPTH, D_MODEL), f32),
        "w_in": nrm(ks[2], (DEPTH, D_MODEL, D_IN), f32) * D_MODEL ** -0.5,
        "conv_w": nrm(ks[3], (DEPTH, CONV_K, 3 * GDN_WIDTH), f32) * CONV_K ** -0.5,
        "a_log": jnp.log(jax.random.uniform(ks[4], (DEPTH, GDN_HEADS), f32, 1.0, 16.0)),
        "dt_bias": dt + jnp.log(-jnp.expm1(-dt)),
        "gdn_norm_w": 1.0 + 0.02 * nrm(ks[6], (DEPTH, GDN_HEAD_DIM), f32),
        "q_norm_w": 1.0 + 0.02 * nrm(ks[7], (DEPTH, DIFF_HEAD_DIM), f32),
        "k_norm_w": 1.0 + 0.02 * nrm(ks[8], (DEPTH, DIFF_HEAD_DIM), f32),
        "lambda_q1": 0.1 * nrm(ks[9], (DEPTH, DIFF_HEAD_DIM), f32),
        "lambda_k1": 0.1 * nrm(ks[10], (DEPTH, DIFF_HEAD_DIM), f32),
        "lambda_q2": 0.1 * nrm(ks[11], (DEPTH, DIFF_HEAD_DIM), f32),
        "lambda_k2": 0.1 * nrm(ks[12], (DEPTH, DIFF_HEAD_DIM), f32),
        "subln_w": 1.0 + 0.02 * nrm(ks[13], (DEPTH, DIFF_V_DIM), f32),
        "w_out": nrm(ks[14], (DEPTH, D_MODEL, D_MODEL), f32) * D_MODEL ** -0.5,
        "norm2_w": 1.0 + 0.02 * nrm(ks[15], (DEPTH, D_MODEL), f32),
        "w_gate": nrm(ks[16], (DEPTH, D_MODEL, D_FF), f32) * D_MODEL ** -0.5,
        "w_up": nrm(ks[17], (DEPTH, D_MODEL, D_FF), f32) * D_MODEL ** -0.5,
        "w_down": nrm(ks[18], (DEPTH, D_FF, D_MODEL), f32) * D_FF ** -0.5,
    }


def reference(x, norm1_w, w_in, conv_w, a_log, dt_bias, gdn_norm_w, q_norm_w, k_norm_w,
              lambda_q1, lambda_k1, lambda_q2, lambda_k2, subln_w, w_out, norm2_w,
              w_gate, w_up, w_down):
    h = x
    for l in range(DEPTH):
        lambda_init = 0.8 - 0.6 * math.exp(-0.3 * l)
        u = rms_norm(h, norm1_w[l])
        proj = u @ w_in[l]
        (gq, gk, gv, gz, ga, gb, dq, dk, dv, gate_a, gate_b) = jnp.split(proj, SPLIT_POINTS, axis=-1)
        o_a = gated_delta_net(gq, gk, gv, gz, ga, gb, conv_w[l], a_log[l], dt_bias[l],
                              gdn_norm_w[l]).astype(h.dtype)
        o_b = diff_attention(dq, dk, dv, q_norm_w[l], k_norm_w[l], lambda_q1[l], lambda_k1[l],
                             lambda_q2[l], lambda_k2[l], subln_w[l], lambda_init).astype(h.dtype)
        mixed = jax.nn.sigmoid(gate_a) * o_a + jax.nn.sigmoid(gate_b) * o_b
        h = h + mixed @ w_out[l]
        u = rms_norm(h, norm2_w[l])
        h = h + (jax.nn.silu(u @ w_gate[l]) * (u @ w_up[l])) @ w_down[l]
    return h
```

```cpp
#include <hip/hip_runtime.h>
#include <hip/hip_cooperative_groups.h>
#include <cstdio>
#include <cstdint>
namespace cg = cooperative_groups;
namespace pg8 {
#define PG8_LAS __attribute__((address_space(3)))
typedef unsigned short bf16_t;
typedef short bf16x8 __attribute__((ext_vector_type(8)));
typedef float f32x4 __attribute__((ext_vector_type(4)));
typedef unsigned u32x4 __attribute__((ext_vector_type(4)));
constexpr int BM = 256, BK = 64, HALF = 128, HTB = HALF * BK * 2  , STAGE_BYTES = 8 * HTB, NXCD = 8, WGM = 4;

__host__ __device__ __forceinline__ int lds_byte(int r, int c) { const int st = (r >> 4) * 2 + (c >> 5), rr = r & 15, cc = c & 31, ob = rr * 64 + cc * 2; return st * 1024 + (ob ^ (((ob >> 9) & 1) << 5)); }
__host__ __device__ __forceinline__ void stage_rc(int b, int& R, int& C) { const int st = b / 1024, sb = b % 1024, swz = sb ^ (((sb >> 9) & 1) << 5); R = (st >> 1) * 16 + swz / 64; C = (st & 1) * 32 + (swz % 64) / 2; }
__host__ __device__ __forceinline__ int perm32(int rho) { const int n = rho >> 4, i = rho & 15; return 8 * (i >> 2) + 4 * n + (i & 3); }

struct Unit { int pm, pn; };
struct Gemm { const bf16_t* A; const bf16_t* Bt; int M, N, K; };

struct StaticOrder {
    int nM, nN, nwg, G, c;
    __host__ __device__ void init(int M, int N, int G_, int c_) { nM = M / BM; nN = N / BM; nwg = nM * nN; G = G_; c = c_; }
    __host__ __device__ bool next(int i, Unit& u) const {
        const long L = (long)i * G + c; if (L >= nwg) return false;
        int wgid = (int)L; { const int q = nwg / NXCD, r = nwg % NXCD, xcd = wgid % NXCD, off = wgid / NXCD; wgid = (xcd < r ? xcd * (q + 1) : r * (q + 1) + (xcd - r) * q) + off; }
        const int nig = WGM * nN, gid = wgid / nig, fm = gid * WGM, gsz = (nM - fm) < WGM ? (nM - fm) : WGM;
        u.pm = fm + ((wgid % nig) % gsz); u.pn = (wgid % nig) / gsz; return true;
    }
    __device__ __forceinline__ void a_ready(const Unit&) const {}
    __device__ __forceinline__ void done(const Unit&) const {}
};
__device__ __forceinline__ unsigned cvt_pk_bf16(float lo, float hi) { unsigned r; asm volatile("v_cvt_pk_bf16_f32 %0, %1, %2" : "=v"(r) : "v"(lo), "v"(hi)); return r; }
typedef float f32x2v __attribute__((ext_vector_type(2)));
typedef __bf16 bf16x2v __attribute__((ext_vector_type(2)));
__device__ __forceinline__ unsigned pk_bf16(float lo, float hi) { f32x2v v = {lo, hi}; bf16x2v b = __builtin_convertvector(v, bf16x2v); return __builtin_bit_cast(unsigned, b); }
__device__ __forceinline__ u32x4 pk8(const f32x4& a, const f32x4& b) { u32x4 w; w.x = pk_bf16(a[0], a[1]); w.y = pk_bf16(a[2], a[3]); w.z = pk_bf16(b[0], b[1]); w.w = pk_bf16(b[2], b[3]); return w; }

struct EpiProj {
    static constexpr bool PERM = true, AFTER_DRAIN = false;
    bf16_t *o0, *o1, *o2, *o3, *o4; unsigned tile_mask; bf16_t* halo; unsigned norm_mask; const float *nw0, *nw1; int norm_q;
    __device__ __forceinline__ void operator()(const f32x4 (&acc)[2][2][4][2], const Unit& u, int wr, int wc, int fr, int fq) const {
        const int t = u.pn >> 2, c0 = (u.pn & 3) * 256 + wc * 32 + 8 * fq;
        bf16_t* base = t == 0 ? o0 : t == 1 ? o1 : t == 2 ? o2 : t == 3 ? o3 : o4;
        const bool tiled = (tile_mask >> t) & 1u;
        if ((norm_mask >> t) & 1u) {
            const float* nw = t == norm_q ? nw0 : nw1; const float sc = t == norm_q ? 0.125f * 1.4426950408889634f : 1.0f;
#pragma unroll
            for (int ai = 0; ai < 2; ++ai)
#pragma unroll
                for (int m = 0; m < 4; ++m) {
                    const int row = u.pm * BM + ai * HALF + wr * 64 + m * 16 + fr;
                    float ss = 0.f;
#pragma unroll
                    for (int bj = 0; bj < 2; ++bj)
#pragma unroll
                        for (int n = 0; n < 2; ++n) { const f32x4 v = acc[ai][bj][m][n]; ss += (v[0] * v[0] + v[1] * v[1]) + (v[2] * v[2] + v[3] * v[3]); }
                    ss += __shfl_xor(ss, 16); ss += __shfl_xor(ss, 32);
                    const float r = __builtin_amdgcn_rsqf(ss * (1.0f / 64.0f) + 1e-6f) * sc;
#pragma unroll
                    for (int bj = 0; bj < 2; ++bj) {
                        const int col = ((u.pn & 3) * 4 + wc) * 64 + 32 * bj + 8 * fq;
                        const f32x4 w0 = *(const f32x4*)(nw + 32 * bj + 8 * fq), w1 = *(const f32x4*)(nw + 32 * bj + 8 * fq + 4);
                        *(u32x4*)(base + (size_t)row * 1024 + col) = pk8(acc[ai][bj][m][0] * r * w0, acc[ai][bj][m][1] * r * w1);
                    }
                }
            return;
        }
#pragma unroll
        for (int ai = 0; ai < 2; ++ai)
#pragma unroll
            for (int m = 0; m < 4; ++m) {
                const int row = u.pm * BM + ai * HALF + wr * 64 + m * 16 + fr;
#pragma unroll
                for (int bj = 0; bj < 2; ++bj) {
                    const int col = c0 + bj * HALF;
                    const u32x4 w = pk8(acc[ai][bj][m][0], acc[ai][bj][m][1]);
                    if (tiled) {
                        const int h = col >> 7, d = col & 127, chunk = row >> 6, tok = row & 63;
                        *(u32x4*)(base + ((size_t)(chunk * 8 + h) * 64 + tok) * 128 + d) = w;
                        if (tok >= 61) *(u32x4*)(halo + (((size_t)(chunk * 8 + h) * 3 + t) * 3 + (tok - 61)) * 128 + d) = w;
                    } else {
                        *(u32x4*)(base + (size_t)row * 1024 + col) = w;
                    }
                }
            }
    }
};
struct EpiPlain {
    static constexpr bool PERM = true, AFTER_DRAIN = false;
    bf16_t* O; int ldc;
    __device__ __forceinline__ void operator()(const f32x4 (&acc)[2][2][4][2], const Unit& u, int wr, int wc, int fr, int fq) const {
#pragma unroll
        for (int ai = 0; ai < 2; ++ai)
#pragma unroll
            for (int m = 0; m < 4; ++m) {
                const int row = u.pm * BM + ai * HALF + wr * 64 + m * 16 + fr;
#pragma unroll
                for (int bj = 0; bj < 2; ++bj) {
                    const int col = u.pn * BM + bj * HALF + wc * 32 + 8 * fq;
                    *(u32x4*)(O + (size_t)row * ldc + col) = pk8(acc[ai][bj][m][0], acc[ai][bj][m][1]);
                }
            }
    }
};
struct EpiOut {
    static constexpr bool PERM = false, AFTER_DRAIN = false;
    const float* x; float* h1; bf16_t* h1b; float* rowss;
    __device__ __forceinline__ void operator()(const f32x4 (&acc)[2][2][4][2], const Unit& u, int wr, int wc, int fr, int fq) const {
#pragma unroll
        for (int ai = 0; ai < 2; ++ai)
#pragma unroll
            for (int m = 0; m < 4; ++m) {
                const int row = u.pm * BM + ai * HALF + wr * 64 + m * 16 + fr;
                float ss = 0.f;
#pragma unroll
                for (int bj = 0; bj < 2; ++bj)
#pragma unroll
                    for (int n = 0; n < 2; ++n) {
                        const int col = u.pn * BM + bj * HALF + wc * 32 + n * 16 + 4 * fq;
                        const size_t off = (size_t)row * 1024 + col;
                        const f32x4 v = *(const f32x4*)(x + off) + acc[ai][bj][m][n];
                        f32x2v pw; pw.x = __builtin_bit_cast(float, pk_bf16(v[0], v[1])); pw.y = __builtin_bit_cast(float, pk_bf16(v[2], v[3]));
                        *(f32x2v*)(h1b + off) = pw;
                        ss += (v[0] * v[0] + v[1] * v[1]) + (v[2] * v[2] + v[3] * v[3]);
                    }
                ss += __shfl_xor(ss, 16); ss += __shfl_xor(ss, 32);
                if (fq == 0) rowss[(size_t)row * 16 + u.pn * 4 + wc] = ss;
            }
    }
};
struct EpiSwiGLU {
    static constexpr bool PERM = true, AFTER_DRAIN = false;
    const float* rowss; bf16_t* hff; int ldh;
    __device__ __forceinline__ void operator()(const f32x4 (&acc)[2][2][4][2], const Unit& u, int wr, int wc, int fr, int fq) const {
#pragma unroll
        for (int ai = 0; ai < 2; ++ai)
#pragma unroll
            for (int m = 0; m < 4; ++m) {
                const int row = u.pm * BM + ai * HALF + wr * 64 + m * 16 + fr;
                const f32x4* rp = (const f32x4*)(rowss + (size_t)row * 16);
                const f32x4 p0 = rp[0], p1 = rp[1], p2 = rp[2], p3 = rp[3];
                const f32x4 ps = (p0 + p1) + (p2 + p3);
                const float rstd = __builtin_amdgcn_rsqf(((ps[0] + ps[1]) + (ps[2] + ps[3])) * (1.0f / 1024.0f) + 1e-6f);
                f32x4 hv[2];
#pragma unroll
                for (int n = 0; n < 2; ++n) {
                    const f32x4 g = acc[ai][0][m][n] * rstd, up = acc[ai][1][m][n] * rstd;
#pragma unroll
                    for (int e = 0; e < 4; ++e) hv[n][e] = g[e] * __builtin_amdgcn_rcpf(1.0f + __expf(-g[e])) * up[e];
                }
                *(u32x4*)(hff + (size_t)row * ldh + u.pn * 128 + wc * 32 + 8 * fq) = pk8(hv[0], hv[1]);
            }
    }
};
struct EpiDown {
    static constexpr bool PERM = false, AFTER_DRAIN = false;
    float* out; float sc; const bf16_t* h1b;
    __device__ __forceinline__ void operator()(const f32x4 (&acc)[2][2][4][2], const Unit& u, int wr, int wc, int fr, int fq) const {
#pragma unroll
        for (int ai = 0; ai < 2; ++ai)
#pragma unroll
            for (int m = 0; m < 4; ++m) {
                const int row = u.pm * BM + ai * HALF + wr * 64 + m * 16 + fr;
#pragma unroll
                for (int bj = 0; bj < 2; ++bj)
#pragma unroll
                    for (int n = 0; n < 2; ++n) {
                        const size_t off = (size_t)row * 1024 + u.pn * BM + bj * HALF + wc * 32 + n * 16 + 4 * fq;
                        typedef unsigned u32x2e __attribute__((ext_vector_type(2)));
                        const u32x2e hw = *(const u32x2e*)(h1b + off);
                        const f32x4 hv = {__uint_as_float(hw.x << 16), __uint_as_float(hw.x & 0xffff0000u), __uint_as_float(hw.y << 16), __uint_as_float(hw.y & 0xffff0000u)};
                        __builtin_nontemporal_store(hv + acc[ai][bj][m][n] * sc, (f32x4*)(out + off));
                    }
            }
    }
};

template <class Epi, class Sched, bool ALIGN_EPI = false, bool SP2 = false>
__device__ __forceinline__ void gemm_phase(PG8_LAS unsigned char* lds, const Gemm g, const Sched& S, const Epi& E, int wave_s) {
    int tid_o = wave_s * 64 + (int)__builtin_amdgcn_mbcnt_hi(~0u, __builtin_amdgcn_mbcnt_lo(~0u, 0u)); asm volatile("" : "+v"(tid_o));
    const int tid = tid_o, wid = __builtin_amdgcn_readfirstlane(tid >> 6), lane = tid & 63, wr = wid >> 2, wc = wid & 3, fr = lane & 15, fq = lane >> 4;
    const int K = g.K, nt = K / BK;
    unsigned voffA[2], voffB[2];
#pragma unroll
    for (int i = 0; i < 2; ++i) { int R, C; stage_rc(tid * 16 + i * 8192, R, C); const int Rb = Epi::PERM ? ((R & ~31) + perm32(R & 31)) : R;
        voffA[i] = (unsigned)(R * K + C) * 2u; voffB[i] = (unsigned)(Rb * K + C) * 2u; }
    const size_t kstep = (size_t)(BK * 2);
    const size_t hstep = (size_t)HALF * K * 2;
    const size_t tstep = 2 * hstep;
    const unsigned ldsw = (unsigned)wid * 1024u;
    const int aoff = lds_byte(wr * 64 + fr, fq * 8), boff = lds_byte(wc * 32 + fr, fq * 8);
#define PG8_SA(b, h) (((b) * 2 + (h)) * HTB)
#define PG8_SB(b, h) ((4 + (b) * 2 + (h)) * HTB)
#define PG8_STAGE(bufoff, gbase, voff) do { _Pragma("unroll") for (int _i = 0; _i < 2; ++_i) \
        __builtin_amdgcn_global_load_lds((const unsigned*)((const char*)(gbase) + (voff)[_i]), (PG8_LAS unsigned*)(lds + (bufoff) + ldsw + _i * 8192), 16, 0, 0); } while (0)
#define PG8_LDA(dst, b, h) do { _Pragma("unroll") for (int m = 0; m < 4; ++m) _Pragma("unroll") for (int k = 0; k < 2; ++k) dst[m][k] = *(const PG8_LAS bf16x8*)(lds + PG8_SA(b, h) + aoff + m * 2048 + k * 1024); } while (0)
#define PG8_LDB(dst, b, h) do { _Pragma("unroll") for (int n = 0; n < 2; ++n) _Pragma("unroll") for (int k = 0; k < 2; ++k) dst[n][k] = *(const PG8_LAS bf16x8*)(lds + PG8_SB(b, h) + boff + n * 2048 + k * 1024); } while (0)
#define PG8_MMA(ai, bj, At, Bt) do { __builtin_amdgcn_s_setprio(1); _Pragma("unroll") for (int m = 0; m < 4; ++m) _Pragma("unroll") for (int n = 0; n < 2; ++n) _Pragma("unroll") for (int k = 0; k < 2; ++k) \
        acc[ai][bj][m][n] = __builtin_amdgcn_mfma_f32_16x16x32_bf16(Bt[n][k], At[m][k], acc[ai][bj][m][n], 0, 0, 0); __builtin_amdgcn_s_setprio(0); } while (0)
#define PG8_WAIT_V(n) asm volatile("s_waitcnt vmcnt(" #n ")" ::: "memory")
#define PG8_WAIT_L(n) asm volatile("s_waitcnt lgkmcnt(" #n ")" ::: "memory")
#define PG8_BAR __builtin_amdgcn_s_barrier()
#define PG8_SCHED __builtin_amdgcn_sched_barrier(0)
    Unit cur, nxt; int ui = 0;
    if (!S.next(0, cur)) return;
    f32x4 acc[2][2][4][2];
#pragma unroll
    for (int a = 0; a < 2; ++a)
#pragma unroll
        for (int b = 0; b < 2; ++b)
#pragma unroll
            for (int m = 0; m < 4; ++m)
#pragma unroll
                for (int n = 0; n < 2; ++n) acc[a][b][m][n] = (f32x4){0.f, 0.f, 0.f, 0.f};
    bf16x8 At[4][2], B0[2][2], B1[2][2];
    const char* cA = (const char*)g.A + (size_t)cur.pm * tstep; const char* cB = (const char*)g.Bt + (size_t)cur.pn * tstep;
    S.a_ready(cur);
    if constexpr (SP2) {
        PG8_STAGE(PG8_SB(0, 0), cB, voffB); PG8_STAGE(PG8_SB(0, 1), cB + hstep, voffB); PG8_STAGE(PG8_SA(0, 0), cA, voffA); PG8_STAGE(PG8_SA(0, 1), cA + hstep, voffA);
        if (wr == 1) PG8_BAR;
        PG8_WAIT_V(2); PG8_BAR;
        PG8_STAGE(PG8_SB(1, 0), cB + kstep, voffB); PG8_STAGE(PG8_SA(1, 0), cA + kstep, voffA); PG8_STAGE(PG8_SB(1, 1), cB + hstep + kstep, voffB);
        PG8_WAIT_V(6); PG8_BAR;
    } else {
        PG8_STAGE(PG8_SB(0, 0), cB, voffB); PG8_STAGE(PG8_SA(0, 0), cA, voffA); PG8_STAGE(PG8_SB(0, 1), cB + hstep, voffB); PG8_STAGE(PG8_SA(0, 1), cA + hstep, voffA);
        if (wr == 1) PG8_BAR;
        PG8_WAIT_V(4); PG8_BAR;
        PG8_STAGE(PG8_SB(1, 0), cB + kstep, voffB); PG8_STAGE(PG8_SA(1, 0), cA + kstep, voffA); PG8_STAGE(PG8_SB(1, 1), cB + hstep + kstep, voffB);
        PG8_WAIT_V(6); PG8_BAR;
    }
    for (;;) {
        const bool has_next = S.next(ui + 1, nxt);
        const char* nA = has_next ? (const char*)g.A + (size_t)nxt.pm * tstep : cA; const char* nB = has_next ? (const char*)g.Bt + (size_t)nxt.pn * tstep : cB;
        for (int t = 0; t < nt; t += 2) {
            const bool last = (t == nt - 2);
            const char* a1 = cA + (size_t)(t + 1) * kstep;
            const char* a2 = last ? nA : cA + (size_t)(t + 2) * kstep; const char* b2 = last ? nB : cB + (size_t)(t + 2) * kstep;
            const char* a3 = a2 + kstep; const char* b3 = b2 + kstep;
            if (last && has_next) S.a_ready(nxt);
            if constexpr (SP2) {
            PG8_LDB(B0, 0, 0); PG8_LDB(B1, 0, 1); PG8_SCHED; PG8_LDA(At, 0, 0); PG8_STAGE(PG8_SA(1, 1), a1 + hstep, voffA);
            PG8_WAIT_V(8); PG8_WAIT_L(0); PG8_BAR; PG8_MMA(0, 0, At, B0); PG8_MMA(0, 1, At, B1); PG8_BAR; PG8_SCHED;
            PG8_LDA(At, 0, 1); PG8_STAGE(PG8_SB(0, 0), b2, voffB); PG8_STAGE(PG8_SB(0, 1), b2 + hstep, voffB); PG8_STAGE(PG8_SA(0, 0), a2, voffA);
            PG8_WAIT_V(8); PG8_WAIT_L(0); PG8_BAR; PG8_MMA(1, 0, At, B0); PG8_MMA(1, 1, At, B1); PG8_BAR; PG8_SCHED;
            PG8_LDB(B0, 1, 0); PG8_LDB(B1, 1, 1); PG8_SCHED; PG8_LDA(At, 1, 0); PG8_STAGE(PG8_SA(0, 1), a2 + hstep, voffA);
            PG8_WAIT_V(8); PG8_WAIT_L(0); PG8_BAR; PG8_MMA(0, 0, At, B0); PG8_MMA(0, 1, At, B1); PG8_BAR; PG8_SCHED;
            PG8_LDA(At, 1, 1); PG8_STAGE(PG8_SB(1, 0), b3, voffB); PG8_STAGE(PG8_SB(1, 1), b3 + hstep, voffB); PG8_STAGE(PG8_SA(1, 0), a3, voffA);
            PG8_WAIT_V(8); PG8_WAIT_L(0); PG8_BAR; PG8_MMA(1, 0, At, B0); PG8_MMA(1, 1, At, B1); PG8_BAR; PG8_SCHED;
            } else {
            PG8_LDB(B0, 0, 0); PG8_SCHED; PG8_LDA(At, 0, 0); PG8_STAGE(PG8_SA(1, 1), a1 + hstep, voffA);
            PG8_WAIT_L(8); PG8_BAR; PG8_WAIT_L(0); PG8_MMA(0, 0, At, B0); PG8_BAR; PG8_SCHED;
            PG8_LDB(B1, 0, 1); PG8_STAGE(PG8_SB(0, 0), b2, voffB);
            PG8_BAR; PG8_WAIT_L(0); PG8_MMA(0, 1, At, B1); PG8_BAR;
            PG8_LDA(At, 0, 1); PG8_STAGE(PG8_SA(0, 0), a2, voffA);
            PG8_BAR; PG8_WAIT_L(0); PG8_MMA(1, 0, At, B0); PG8_BAR; PG8_SCHED;
            PG8_STAGE(PG8_SB(0, 1), b2 + hstep, voffB);
            PG8_WAIT_V(6); PG8_BAR; PG8_MMA(1, 1, At, B1); PG8_BAR;
            PG8_LDB(B0, 1, 0); PG8_SCHED; PG8_LDA(At, 1, 0); PG8_STAGE(PG8_SA(0, 1), a2 + hstep, voffA);
            PG8_WAIT_L(8); PG8_BAR; PG8_WAIT_L(0); PG8_MMA(0, 0, At, B0); PG8_BAR; PG8_SCHED;
            PG8_LDB(B1, 1, 1); PG8_STAGE(PG8_SB(1, 0), b3, voffB);
            PG8_BAR; PG8_WAIT_L(0); PG8_MMA(0, 1, At, B1); PG8_BAR;
            PG8_LDA(At, 1, 1); PG8_STAGE(PG8_SA(1, 0), a3, voffA);
            PG8_BAR; PG8_WAIT_L(0); PG8_MMA(1, 0, At, B0); PG8_BAR; PG8_SCHED;
            PG8_STAGE(PG8_SB(1, 1), b3 + hstep, voffB);
            PG8_WAIT_V(6); PG8_BAR; PG8_MMA(1, 1, At, B1); PG8_BAR;
            }
        }
        if constexpr (ALIGN_EPI) { if (wr == 0) PG8_BAR; }
        if constexpr (!Epi::AFTER_DRAIN) { E(acc, cur, wr, wc, fr, fq); S.done(cur); }
        if (!has_next) break;
#pragma unroll
        for (int a = 0; a < 2; ++a)
#pragma unroll
            for (int b = 0; b < 2; ++b)
#pragma unroll
                for (int m = 0; m < 4; ++m)
#pragma unroll
                    for (int n = 0; n < 2; ++n) acc[a][b][m][n] = (f32x4){0.f, 0.f, 0.f, 0.f};
        cur = nxt; cA = nA; cB = nB; ++ui;
        if constexpr (ALIGN_EPI) { if (wr == 1) PG8_BAR; }
    }
    PG8_WAIT_V(0);
    if constexpr (!ALIGN_EPI) { if (wr == 0) PG8_BAR; }
    PG8_BAR;
    if constexpr (Epi::AFTER_DRAIN) { E.fused(acc, cur, wr, wc, fr, fq, lds, wid, lane); S.done(cur); }
#undef PG8_SA
#undef PG8_SB
#undef PG8_STAGE
#undef PG8_LDA
#undef PG8_LDB
#undef PG8_MMA
#undef PG8_WAIT_V
#undef PG8_WAIT_L
#undef PG8_BAR
#undef PG8_SCHED
}
}

typedef unsigned short bf16;
typedef float f32x4 __attribute__((ext_vector_type(4)));
typedef unsigned u32x4 __attribute__((ext_vector_type(4)));
typedef unsigned u32x2 __attribute__((ext_vector_type(2)));
typedef short bf16x8 __attribute__((ext_vector_type(8)));
#define LAS __attribute__((address_space(3)))

constexpr int NB = 8, SEQ = 2048, DM = 1024, NH = 8, FF = 2816, DIN = 9232;
constexpr int M = NB * SEQ;
constexpr float EPS = 1e-6f;
constexpr float LAMBDA_INIT = 0.2f;
constexpr size_t MiB = 1u << 20;
constexpr size_t WS_G = 1 * MiB, WS_BETA = 1 * MiB + 512 * 1024, WS_HALO = 2 * MiB, WS_RSS = 7 * MiB;
constexpr size_t WS_WIN = 8 * MiB, WS_WOUT = 26 * MiB, WS_WGU = 28 * MiB, WS_WD = 39 * MiB;
constexpr size_t WS_GZ = 45 * MiB, WS_GA = 77 * MiB, WS_TQ = 109 * MiB, WS_TK = 141 * MiB, WS_TV = 173 * MiB, WS_AQK = 205 * MiB;
constexpr size_t WS_DQ = 109 * MiB, WS_DK = 141 * MiB, WS_DVT = 173 * MiB, WS_GB = 205 * MiB;
constexpr size_t WS_H1B = 77 * MiB, WS_HFF = 109 * MiB;
constexpr size_t WS_U = 221 * MiB, WS_GL = 512 * 1024;
constexpr size_t WS_NEED = 253 * MiB;
constexpr int LDS_BYTES = 147456, MISC_OFF = 131072;

__device__ __forceinline__ float bf2f(unsigned short v) { return __uint_as_float((unsigned)v << 16); }
__device__ __forceinline__ unsigned f2bf(float f) { return pg8::pk_bf16(f, 0.f) & 0xffffu; }
__device__ __forceinline__ unsigned pk2(float lo, float hi) { return pg8::pk_bf16(lo, hi); }
__device__ __forceinline__ float lo16(unsigned w) { return __uint_as_float(w << 16); }
__device__ __forceinline__ float hi16(unsigned w) { return __uint_as_float(w & 0xffff0000u); }
__device__ __forceinline__ float sigmoidf_(float x) { return __builtin_amdgcn_rcpf(1.0f + __expf(-x)); }
__device__ __forceinline__ float siluf_(float x) { return x * __builtin_amdgcn_rcpf(1.0f + __expf(-x)); }
__device__ __forceinline__ void unpack8(const u32x4& w, float* o) { o[0] = lo16(w.x); o[1] = hi16(w.x); o[2] = lo16(w.y); o[3] = hi16(w.y); o[4] = lo16(w.z); o[5] = hi16(w.z); o[6] = lo16(w.w); o[7] = hi16(w.w); }

struct Args { const float* in[19]; float* out; unsigned char* ws; int ph_lo, ph_hi; };
#ifndef G1_REP_A
#define G1_REP_A 1
#endif
#ifndef G1_REP_C
#define G1_REP_C 1
#endif
#ifndef G1_REP_D1
#define G1_REP_D1 1
#endif
#ifndef G1_REP_D2
#define G1_REP_D2 1
#endif
#ifndef G1_REP_E
#define G1_REP_E 1
#endif
#ifndef REP_P1
#define REP_P1 1
#endif
#ifndef REP_P6
#define REP_P6 1
#endif
#ifndef REP_P8
#define REP_P8 1
#endif
#ifndef REP_SYNC
#define REP_SYNC 0
#endif
#ifndef REP_P0
#define REP_P0 1
#endif
#ifndef REP_P1G1
#define REP_P1G1 1
#endif
#ifndef REP_G2
#define REP_G2 1
#endif
#ifndef REP_ATT
#define REP_ATT 1
#endif
#ifndef REP_P4
#define REP_P4 1
#endif
#ifndef REP_P7
#define REP_P7 1
#endif

__device__ __forceinline__ size_t oraw_idx(int row, int h, int e) { return (size_t)row * 1024 + h * 128 + e; }

__device__ __forceinline__ void transpose_item(const float* W, int ldw, int src_col0, bf16* WT, int K, int dst_row0, int k0, const float* kscale, float* scr, int lane) {
    float tv[32];
#pragma unroll
    for (int i = 0; i < 32; ++i) { const int kk = 2 * i + (lane >> 5); tv[i] = __builtin_nontemporal_load(W + (size_t)(k0 + kk) * ldw + src_col0 + (lane & 31)); }
#pragma unroll
    for (int i = 0; i < 32; ++i) { const int kk = 2 * i + (lane >> 5); float v = tv[i]; if (kscale) v *= kscale[k0 + kk]; scr[kk * 33 + (lane & 31)] = v; }
    asm volatile("s_waitcnt lgkmcnt(0)" ::: "memory");
    const int c = lane & 7;
#pragma unroll
    for (int j = 0; j < 4; ++j) { const int n = (lane >> 3) + 8 * j; const float* s = scr + (8 * c) * 33 + n;
        u32x4 o; o.x = pk2(s[0 * 33], s[1 * 33]); o.y = pk2(s[2 * 33], s[3 * 33]); o.z = pk2(s[4 * 33], s[5 * 33]); o.w = pk2(s[6 * 33], s[7 * 33]);
        *(u32x4*)(WT + (size_t)(dst_row0 + n) * K + k0 + 8 * c) = o; }
    asm volatile("s_waitcnt lgkmcnt(0)" ::: "memory");
}
__device__ __forceinline__ int win_src_col(int r) {
    if (r < 4096) return r;
    if (r < 5120) return r - 4096 + 7184;
    if (r < 7168) {
        const int base = r < 6144 ? 4112 : 5136, rr = (r - 5120) & 1023;
        return base + (4 * (rr >> 8) + ((rr >> 5) & 3)) * 64 + 32 * ((rr >> 7) & 1) + (rr & 31);
    }
    if (r < 8192) return r - 7168 + 8208;
    return r - 8192 + 6160;
}
__device__ __forceinline__ void p0_prologue(const Args& a, unsigned char* lds, int tid, int lane, int wave, int vcu, int G) {
    unsigned char* ws = a.ws;
    const int gw = vcu * 8 + wave, NGW = G * 8;
    float* scr = (float*)(lds + 65536 + wave * 8704);
    constexpr int I_IN = 16 * 288, I_OUT = 16 * 32, I_GU = 16 * 176, I_D = 44 * 32, NITEMS = I_IN + I_OUT + I_GU + I_D;
    for (int it = gw; it < NITEMS; it += NGW) {
        int r = it;
        if (r < I_IN) { const int kb = r / 288, nb = r % 288; transpose_item(a.in[2], DIN, win_src_col(nb * 32), (bf16*)(ws + WS_WIN), 1024, nb * 32, kb * 64, nullptr, scr, lane); continue; } r -= I_IN;
        if (r < I_OUT) { const int kb = r / 32, nb = r % 32; transpose_item(a.in[14], 1024, nb * 32, (bf16*)(ws + WS_WOUT), 1024, nb * 32, kb * 64, nullptr, scr, lane); continue; } r -= I_OUT;
        if (r < I_GU) { const int kb = r / 176, nb = r % 176; const int dr = nb * 32, tile = dr >> 8, within = dr & 255;
            const float* W = within < 128 ? a.in[16] : a.in[17]; const int sc = tile * 128 + (within & 127);
            transpose_item(W, FF, sc, (bf16*)(ws + WS_WGU), 1024, dr, kb * 64, a.in[15], scr, lane); continue; } r -= I_GU;
        { const int kb = r / 32, nb = r % 32; transpose_item(a.in[18], 1024, nb * 32, (bf16*)(ws + WS_WD), FF, nb * 32, kb * 64, nullptr, scr, lane); }
    }
    f32x4* wab = (f32x4*)lds;
    for (int i = tid; i < 4096; i += 512) { const int k = i >> 2, q = i & 3, j = k >> 8, l = (k & 255) >> 2, e = k & 3;
        wab[((j * 4 + e) * 4 + q) * 64 + l] = *(const f32x4*)(a.in[2] + (size_t)k * DIN + 4096 + q * 4); }
    __syncthreads();
    const float* x = a.in[0];
    bf16* XN = (bf16*)a.out;
    float* gbuf = (float*)(ws + WS_G); float* bbuf = (float*)(ws + WS_BETA);
    f32x4 n1[4];
#pragma unroll
    for (int j = 0; j < 4; ++j) n1[j] = ((const f32x4*)a.in[1])[64 * j + lane];
    f32x4 xn[4];
    if (gw < M) {
#pragma unroll
        for (int j = 0; j < 4; ++j) xn[j] = __builtin_nontemporal_load((const f32x4*)(x + (size_t)gw * DM) + lane + 64 * j);
    }
    for (int m = gw; m < M; m += NGW) {
        f32x4 t[4]; float ss = 0.f;
#pragma unroll
        for (int j = 0; j < 4; ++j) { const f32x4 v = xn[j]; ss += (v.x * v.x + v.y * v.y) + (v.z * v.z + v.w * v.w); t[j] = v * n1[j]; }
        if (m + NGW < M) {
#pragma unroll
            for (int j = 0; j < 4; ++j) xn[j] = __builtin_nontemporal_load((const f32x4*)(x + (size_t)(m + NGW) * DM) + lane + 64 * j);
        }
        typedef float f32x2q __attribute__((ext_vector_type(2)));
        f32x2q acc2[8];
#pragma unroll
        for (int c = 0; c < 8; ++c) acc2[c] = (f32x2q){0.f, 0.f};
        f32x4 wA[4], wB[4];
#define P0_LDW(Wd, je) do { _Pragma("unroll") for (int q = 0; q < 4; ++q) Wd[q] = wab[(((je)) * 4 + q) * 64 + lane]; } while (0)
#define P0_FMA(Wd, je) do { const float tv_ = t[(je) >> 2][(je) & 3]; const f32x2q tv2_ = {tv_, tv_}; _Pragma("unroll") for (int q = 0; q < 4; ++q) { \
            acc2[q * 2] += tv2_ * (f32x2q){Wd[q].x, Wd[q].y}; acc2[q * 2 + 1] += tv2_ * (f32x2q){Wd[q].z, Wd[q].w}; } } while (0)
        P0_LDW(wA, 0); __builtin_amdgcn_sched_barrier(0);
#pragma unroll
        for (int je = 0; je < 16; je += 2) {
            P0_LDW(wB, je + 1); __builtin_amdgcn_sched_barrier(0); P0_FMA(wA, je); __builtin_amdgcn_sched_barrier(0);
            if (je + 2 < 16) P0_LDW(wA, je + 2);
            __builtin_amdgcn_sched_barrier(0); P0_FMA(wB, je + 1); __builtin_amdgcn_sched_barrier(0);
        }
#undef P0_LDW
#undef P0_FMA
        float acc[16];
#pragma unroll
        for (int c = 0; c < 8; ++c) { acc[2 * c] = acc2[c].x; acc[2 * c + 1] = acc2[c].y; }
#pragma unroll
        for (int o = 1; o < 64; o <<= 1) ss += __shfl_xor(ss, o);
        {
            const bool b5 = lane & 32, b4 = lane & 16, b3 = lane & 8, b2 = lane & 4;
#pragma unroll
            for (int i = 0; i < 8; ++i) { const float send = b5 ? acc[i] : acc[i + 8], keep = b5 ? acc[i + 8] : acc[i]; acc[i] = keep + __shfl_xor(send, 32); }
#pragma unroll
            for (int i = 0; i < 4; ++i) { const float send = b4 ? acc[i] : acc[i + 4], keep = b4 ? acc[i + 4] : acc[i]; acc[i] = keep + __shfl_xor(send, 16); }
#pragma unroll
            for (int i = 0; i < 2; ++i) { const float send = b3 ? acc[i] : acc[i + 2], keep = b3 ? acc[i + 2] : acc[i]; acc[i] = keep + __shfl_xor(send, 8); }
            { const float send = b2 ? acc[0] : acc[1], keep = b2 ? acc[1] : acc[0]; acc[0] = keep + __shfl_xor(send, 4); }
            acc[0] += __shfl_xor(acc[0], 2); acc[0] += __shfl_xor(acc[0], 1);
        }
        const float rstd = __builtin_amdgcn_rsqf(ss * (1.0f / DM) + EPS);
        u32x2* o8 = (u32x2*)(XN + (size_t)m * DM) + lane;
#pragma unroll
        for (int j = 0; j < 4; ++j) { u32x2 w; w.x = pk2(t[j].x * rstd, t[j].y * rstd); w.y = pk2(t[j].z * rstd, t[j].w * rstd); o8[64 * j] = w; }
        if ((lane & 3) == 0) {
            const int c = ((lane & 32) ? 8 : 0) + ((lane & 16) ? 4 : 0) + ((lane & 8) ? 2 : 0) + ((lane & 4) ? 1 : 0);
            const float v = acc[0] * rstd;
            if (c < 8) { const float z = v + a.in[5][c]; const float sp = (z > 20.f) ? z : log1pf(expf(z)); gbuf[(size_t)m * 8 + c] = -expf(a.in[4][c]) * sp; }
            else bbuf[(size_t)m * 8 + (c - 8)] = 1.0f / (1.0f + expf(-v));
        }
    }
}

__device__ __forceinline__ void g1_load_raw(const Args& a, int item, int tid, u32x4 (&raw)[11]) {
    const int chunk = item >> 3, h = item & 7, n = chunk & 31, t = tid >> 7, c8 = tid & 15, toct = (tid >> 4) & 7;
    if (t < 3) {
        const bf16* tile = (const bf16*)(a.ws + (t == 0 ? WS_TQ : t == 1 ? WS_TK : WS_TV)) + (size_t)item * 8192;
        const bf16* hal = (const bf16*)(a.ws + WS_HALO) + ((size_t)((chunk - 1) * 8 + h) * 3 + t) * 384;
#pragma unroll
        for (int r = 0; r < 11; ++r) {
            const int tok = toct * 8 - 3 + r;
            u32x4 w = {0u, 0u, 0u, 0u};
            if (tok >= 0) w = *(const u32x4*)(tile + tok * 128 + c8 * 8);
            else if (n > 0) w = *(const u32x4*)(hal + (tok + 3) * 128 + c8 * 8);
            raw[r] = w;
        }
    }
}
__device__ __forceinline__ void g1_item(const Args& a, unsigned char* lds, int item, int next_item, u32x4 (&raw)[11], int tid_in, int lane_in, int wave) {
    int tid = tid_in; asm volatile("" : "+v"(tid));
    const int lane = tid & 63; (void)lane_in;
    unsigned char* ws = a.ws;
    const int chunk = item >> 3, h = item & 7, n = chunk & 31;
    unsigned char* QS = lds; unsigned char* KS = lds + 16384;
    constexpr int RS = 264;
    bf16* RHS = (bf16*)(lds + 32768);
    constexpr int WS_ = 136, AS_ = 72;
    bf16* QDR = (bf16*)(lds + 66560);
    constexpr int KTS = 72;
    bf16* KDT = (bf16*)(lds + 83968);
    float* LM = (float*)(lds + 102400); bf16* AQR = (bf16*)(lds + 118784);
    float* gcs = (float*)(lds + 128000); float* egc = gcs + 64; float* bet = gcs + 128; float* ekd = gcs + 192;
    bf16* LB = (bf16*)(lds + 129024);
    bf16* TB = (bf16*)(lds + 138240);
    bf16* WROW = (bf16*)lds;
    const float* gbuf = (const float*)(ws + WS_G); const float* bbuf = (const float*)(ws + WS_BETA);
    unsigned char* blobW = ws + WS_TQ + (size_t)item * 16384; unsigned char* blobQD = ws + WS_TK + (size_t)item * 16384; unsigned char* blobKD = ws + WS_TV + (size_t)item * 16384;
    unsigned char* blobA = ws + WS_AQK + (size_t)item * 8192; unsigned char* blobU = ws + WS_U + (size_t)item * 16384;
    if (wave == 7) {
        const int row = chunk * 64 + lane;
        float sc = gbuf[(size_t)row * 8 + h];
#pragma unroll
        for (int o = 1; o < 64; o <<= 1) { const float t = __shfl_up(sc, o); if (lane >= o) sc += t; }
        const float glast = __shfl(sc, 63);
        gcs[lane] = sc; egc[lane] = __expf(sc); bet[lane] = bbuf[(size_t)row * 8 + h]; ekd[lane] = __expf(glast - sc);
        if (lane == 0) ((float*)(ws + WS_GL))[item] = __expf(glast);
    }
    {
    const int t = tid >> 7, c8 = tid & 15, toct = (tid >> 4) & 7;
    float outv[8][8];
    if (t < 3) {
        float xin[11][8];
#pragma unroll
        for (int r = 0; r < 11; ++r) unpack8(raw[r], xin[r]);
        float cw[4][8];
#pragma unroll
        for (int j = 0; j < 4; ++j) { const float* p = a.in[3] + (size_t)j * 3072 + t * 1024 + h * 128 + c8 * 8; const f32x4 w0 = *(const f32x4*)p, w1 = *(const f32x4*)(p + 4);
            cw[j][0] = w0.x; cw[j][1] = w0.y; cw[j][2] = w0.z; cw[j][3] = w0.w; cw[j][4] = w1.x; cw[j][5] = w1.y; cw[j][6] = w1.z; cw[j][7] = w1.w; }
#pragma unroll
        for (int i = 0; i < 8; ++i) {
            float ss = 0.f;
#pragma unroll
            for (int e = 0; e < 8; ++e) { float sv = 0.f;
#pragma unroll
                for (int j = 0; j < 4; ++j) sv += cw[j][e] * xin[i + j][e];
                sv = siluf_(sv); outv[i][e] = sv; ss += sv * sv; }
            if (t < 2) {
                ss += __shfl_xor(ss, 1); ss += __shfl_xor(ss, 2); ss += __shfl_xor(ss, 4); ss += __shfl_xor(ss, 8);
                const float sc = __builtin_amdgcn_rsqf(ss + EPS) * (t == 0 ? 0.08838834764831845f : 1.0f);
#pragma unroll
                for (int e = 0; e < 8; ++e) outv[i][e] *= sc;
            }
        }
    }
    __syncthreads();
    if (t < 3) {
        float fbe[8], feg[8], fkd[8];
        { const f32x4 b0 = *(const f32x4*)(bet + toct * 8), b1 = *(const f32x4*)(bet + toct * 8 + 4), e0 = *(const f32x4*)(egc + toct * 8), e1 = *(const f32x4*)(egc + toct * 8 + 4),
                      k0 = *(const f32x4*)(ekd + toct * 8), k1 = *(const f32x4*)(ekd + toct * 8 + 4);
#pragma unroll
          for (int q = 0; q < 4; ++q) { fbe[q] = b0[q]; fbe[4 + q] = b1[q]; feg[q] = e0[q]; feg[4 + q] = e1[q]; fkd[q] = k0[q]; fkd[4 + q] = k1[q]; } }
#pragma unroll
        for (int i8 = 0; i8 < 8; ++i8) {
            const int tok = toct * 8 + i8;
            if (t < 2) {
                u32x4 w; w.x = pk2(outv[i8][0], outv[i8][1]); w.y = pk2(outv[i8][2], outv[i8][3]); w.z = pk2(outv[i8][4], outv[i8][5]); w.w = pk2(outv[i8][6], outv[i8][7]);
                *(u32x4*)((t == 0 ? QS : KS) + ((((tok >> 4) * 4 + (c8 >> 2)) * 64) + (c8 & 3) * 16 + ((tok & 15) ^ (2 * (c8 & 3)) ^ ((c8 >> 2) & 1))) * 16) = w;
            }
            if (t >= 1) {
                const float f = (t == 1) ? fbe[i8] * feg[i8] : fbe[i8];
                u32x4 w; w.x = pk2(outv[i8][0] * f, outv[i8][1] * f); w.y = pk2(outv[i8][2] * f, outv[i8][3] * f); w.z = pk2(outv[i8][4] * f, outv[i8][5] * f); w.w = pk2(outv[i8][6] * f, outv[i8][7] * f);
                *(u32x4*)(RHS + tok * RS + (t == 1 ? 128 : 0) + c8 * 8) = w;
            }
            if (t == 0) {
                const float f = feg[i8];
                u32x4 w; w.x = pk2(outv[i8][0] * f, outv[i8][1] * f); w.y = pk2(outv[i8][2] * f, outv[i8][3] * f); w.z = pk2(outv[i8][4] * f, outv[i8][5] * f); w.w = pk2(outv[i8][6] * f, outv[i8][7] * f);
                *(u32x4*)(QDR + tok * WS_ + c8 * 8) = w;
            }
        }
        if (t == 1) {
            float f[8];
#pragma unroll
            for (int i8 = 0; i8 < 8; ++i8) f[i8] = fkd[i8];
#pragma unroll
            for (int e = 0; e < 8; ++e) {
                u32x4 w; w.x = pk2(outv[0][e] * f[0], outv[1][e] * f[1]); w.y = pk2(outv[2][e] * f[2], outv[3][e] * f[3]); w.z = pk2(outv[4][e] * f[4], outv[5][e] * f[5]); w.w = pk2(outv[6][e] * f[6], outv[7][e] * f[7]);
                *(u32x4*)(KDT + (c8 * 8 + e) * KTS + (toct ^ (c8 & 7)) * 8) = w;
            }
        }
    }
    __syncthreads();
    if (next_item >= 0) g1_load_raw(a, next_item, tid, raw);
    }
    {
    {
        const int prod = wave >> 2, it = wave & 3, i16 = lane & 15, g = lane >> 4;
        const unsigned char* AS = prod == 0 ? KS : QS;
        bf16x8 af[4], bfr[4][4];
#pragma unroll
        for (int ks = 0; ks < 4; ++ks) af[ks] = *(const bf16x8*)(AS + (((it * 4 + ks) * 64) + g * 16 + (i16 ^ (2 * g) ^ (ks & 1))) * 16);
#pragma unroll
        for (int jt = 0; jt < 4; ++jt)
            if (jt <= it) {
#pragma unroll
                for (int ks = 0; ks < 4; ++ks) bfr[jt][ks] = *(const bf16x8*)(KS + (((jt * 4 + ks) * 64) + g * 16 + (i16 ^ (2 * g) ^ (ks & 1))) * 16);
            }
        const f32x4 gci = *(const f32x4*)(gcs + 16 * it + 4 * g), bti = *(const f32x4*)(bet + 16 * it + 4 * g);
        float gcj[4];
#pragma unroll
        for (int jt = 0; jt < 4; ++jt) gcj[jt] = gcs[16 * jt + i16];
        __builtin_amdgcn_sched_barrier(0);
        f32x4 accs[4];
#pragma unroll
        for (int jt = 0; jt < 4; ++jt) {
            f32x4 a0 = {0.f, 0.f, 0.f, 0.f}, a1 = {0.f, 0.f, 0.f, 0.f};
            if (jt <= it) {
                a0 = __builtin_amdgcn_mfma_f32_16x16x32_bf16(af[0], bfr[jt][0], a0, 0, 0, 0); a1 = __builtin_amdgcn_mfma_f32_16x16x32_bf16(af[1], bfr[jt][1], a1, 0, 0, 0);
                a0 = __builtin_amdgcn_mfma_f32_16x16x32_bf16(af[2], bfr[jt][2], a0, 0, 0, 0); a1 = __builtin_amdgcn_mfma_f32_16x16x32_bf16(af[3], bfr[jt][3], a1, 0, 0, 0);
            }
            accs[jt] = a0 + a1;
        }
#pragma unroll
        for (int jt = 0; jt < 4; ++jt) {
            const f32x4 acc = accs[jt];
            const int j = 16 * jt + i16; const float gj = gcj[jt];
#pragma unroll
            for (int r = 0; r < 4; ++r) {
                const int i = 16 * it + 4 * g + r;
                const float dec = __expf(fminf(gci[r] - gj, 0.f));
                if (prod == 0) { if (jt <= it) { const float lv0 = bti[r] * acc[r] * dec; const float lv = (i > j) ? lv0 : 0.f; if (jt == it) LM[i * 64 + j] = lv; LB[i * AS_ + j] = (bf16)f2bf(-lv); } }
                else { const float av0 = acc[r] * dec; AQR[i * AS_ + j] = (bf16)f2bf((jt <= it && i >= j) ? av0 : 0.f); }
            }
        }
    }
    if (wave < 4) {
        int vz; asm volatile("v_mov_b32 %0, 0" : "=v"(vz));
        const int c = lane & 15;
        const f32x4* Lb4 = (const f32x4*)(LM + (16 * wave) * 64 + 16 * wave) + vz;
        float T[16];
        f32x4 rowA[4], rowB[4];
#define D1_LD(R, i) do { _Pragma("unroll") for (int q = 0; q < 4; ++q) if (4 * q < (i)) R[q] = Lb4[(i) * 16 + q]; } while (0)
#define D1_ROW(R, i) do { float sacc = ((i) == c) ? 1.0f : 0.0f; _Pragma("unroll") for (int j = 0; j < (i); ++j) sacc -= R[j >> 2][j & 3] * T[j]; T[i] = sacc; } while (0)
        T[0] = (c == 0) ? 1.0f : 0.0f;
        D1_LD(rowA, 1); __builtin_amdgcn_sched_barrier(0);
#pragma unroll
        for (int i = 1; i < 16; i += 2) {
            D1_LD(rowB, i + 1); __builtin_amdgcn_sched_barrier(0); D1_ROW(rowA, i); __builtin_amdgcn_sched_barrier(0);
            if (i + 1 < 16) { if (i + 2 < 16) D1_LD(rowA, i + 2); __builtin_amdgcn_sched_barrier(0); D1_ROW(rowB, i + 1); __builtin_amdgcn_sched_barrier(0); }
        }
#undef D1_LD
#undef D1_ROW
        if (lane < 16) {
#pragma unroll
            for (int i = 0; i < 16; ++i) TB[(wave * 16 + i) * 16 + c] = (bf16)f2bf(T[i]);
        }
    }
    __syncthreads();
    }
    {
    {
        typedef short bf16x4 __attribute__((ext_vector_type(4)));
        const int i16 = lane & 15, g = lane >> 4;
        bf16x4 lf[4][3], tf[4]; float rh[2][4][4];
#pragma unroll
        for (int bb = 0; bb < 4; ++bb) {
            tf[bb] = *(const bf16x4*)(TB + (bb * 16 + i16) * 16 + 4 * g);
#pragma unroll
            for (int b2 = 0; b2 < 3; ++b2) if (b2 < bb) lf[bb][b2] = *(const bf16x4*)(LB + (16 * bb + i16) * AS_ + 16 * b2 + 4 * g);
#pragma unroll
            for (int ct = 0; ct < 2; ++ct)
#pragma unroll
                for (int r = 0; r < 4; ++r) rh[ct][bb][r] = bf2f(RHS[(16 * bb + 4 * g + r) * RS + (ct == 0 ? 0 : 128) + 16 * wave + i16]);
        }
        __builtin_amdgcn_sched_barrier(0);
        bf16x4 xb[2][4];
#pragma unroll
        for (int bb = 0; bb < 4; ++bb) {
            f32x4 acc[2];
#pragma unroll
            for (int ct = 0; ct < 2; ++ct) acc[ct] = (f32x4){rh[ct][bb][0], rh[ct][bb][1], rh[ct][bb][2], rh[ct][bb][3]};
#pragma unroll
            for (int b2 = 0; b2 < 3; ++b2) if (b2 < bb) {
#pragma unroll
                for (int ct = 0; ct < 2; ++ct) acc[ct] = __builtin_amdgcn_mfma_f32_16x16x16bf16_1k(lf[bb][b2], xb[ct][b2], acc[ct], 0, 0, 0);
            }
            f32x4 X[2];
#pragma unroll
            for (int ct = 0; ct < 2; ++ct) { u32x2 pa; pa.x = pk2(acc[ct][0], acc[ct][1]); pa.y = pk2(acc[ct][2], acc[ct][3]);
                X[ct] = __builtin_amdgcn_mfma_f32_16x16x16bf16_1k(tf[bb], __builtin_bit_cast(bf16x4, pa), (f32x4){0.f, 0.f, 0.f, 0.f}, 0, 0, 0); }
#pragma unroll
            for (int ct = 0; ct < 2; ++ct) { u32x2 px; px.x = pk2(X[ct][0], X[ct][1]); px.y = pk2(X[ct][2], X[ct][3]); xb[ct][bb] = __builtin_bit_cast(bf16x4, px);
                if (ct == 0) *(u32x2*)(blobU + (size_t)(((wave * 4 + bb) * 64) + lane) * 8) = px;
                else {
#pragma unroll
                    for (int r = 0; r < 4; ++r) WROW[(16 * bb + 4 * g + r) * WS_ + 16 * wave + i16] = (bf16)(((r & 2) ? px.y : px.x) >> ((r & 1) * 16));
                } }
        }
    }
    __syncthreads();
    }
    {
#pragma unroll
    for (int j = 0; j < 2; ++j) { const int f = tid + 512 * j, frag = f >> 6, ln = f & 63, i = ln & 15, g = ln >> 4, it = frag >> 2, ks = frag & 3;
        const bf16* src = WROW + (16 * it + i) * WS_ + 32 * ks + 4 * g;
        const u32x2 p0 = *(const u32x2*)src, p1 = *(const u32x2*)(src + 16);
        *(u32x4*)(blobW + f * 16) = (u32x4){p0.x, p0.y, p1.x, p1.y}; }
#pragma unroll
    for (int j = 0; j < 2; ++j) { const int f = tid + 512 * j, frag = f >> 6, ln = f & 63, i = ln & 15, g = ln >> 4, it = frag >> 2, ks = frag & 3;
        const bf16* src = QDR + (16 * it + i) * WS_ + 32 * ks + 4 * g;
        const u32x2 p0 = *(const u32x2*)src, p1 = *(const u32x2*)(src + 16);
        *(u32x4*)(blobQD + f * 16) = (u32x4){p0.x, p0.y, p1.x, p1.y}; }
#pragma unroll
    for (int j = 0; j < 2; ++j) { const int f = tid + 512 * j, frag = f >> 6, ln = f & 63, i = ln & 15, g = ln >> 4, dt = frag >> 1, ks2 = frag & 1;
        const int ksw = (2 * dt + (i >> 3)) & 7;
        const bf16* rowp = KDT + (16 * dt + i) * KTS + 4 * (g & 1);
        const u32x2 p0 = *(const u32x2*)(rowp + (((4 * ks2 + (g >> 1)) ^ ksw) * 8)), p1 = *(const u32x2*)(rowp + (((4 * ks2 + 2 + (g >> 1)) ^ ksw) * 8));
        *(u32x4*)(blobKD + f * 16) = (u32x4){p0.x, p0.y, p1.x, p1.y}; }
    {
        const int f = tid, frag = f >> 6, ln = f & 63, i = ln & 15, g = ln >> 4, it = frag >> 1, ks2 = frag & 1;
        const bf16* src = AQR + (16 * it + i) * AS_ + 32 * ks2 + 4 * g;
        const u32x2 p0 = *(const u32x2*)src, p1 = *(const u32x2*)(src + 16);
        *(u32x4*)(blobA + f * 16) = (u32x4){p0.x, p0.y, p1.x, p1.y};
    }
    }
}

__device__ __forceinline__ void g2_item(const Args& a, unsigned char* lds, int item, int tid, int lane, int wave) {
    unsigned char* ws = a.ws;
    const int bh = item >> 2, eq = item & 3, b = bh >> 3, h = bh & 7, et = eq * 2 + (wave & 1);
    bf16* ORAW = (bf16*)a.out + (size_t)M * DM;
    const float* GL = (const float*)(ws + WS_GL);
    constexpr int STG = 57344;
    f32x4 S[8];
#pragma unroll
    for (int dt = 0; dt < 8; ++dt) S[dt] = (f32x4){0.f, 0.f, 0.f, 0.f};
    u32x2 uA[4];
#define G2_SRC(IT8, j) ((j) < 2 ? ws + WS_TQ + (IT8) * 16384 + (size_t)(tid + 512 * (j)) * 16 : (j) < 4 ? ws + WS_TK + (IT8) * 16384 + (size_t)(tid + 512 * ((j) - 2)) * 16 \
        : (j) < 6 ? ws + WS_TV + (IT8) * 16384 + (size_t)(tid + 512 * ((j) - 4)) * 16 : ws + WS_AQK + (IT8) * 8192 + (size_t)tid * 16)
#define G2_DMA(N) do { const size_t it8_ = (size_t)(b * 32 + (N)) * 8 + h; LAS unsigned char* nb_ = (LAS unsigned char*)lds + ((N) & 1) * STG + wave * 1024; \
        _Pragma("unroll") for (int j = 0; j < 7; ++j) __builtin_amdgcn_global_load_lds((const unsigned*)G2_SRC(it8_, j), (LAS unsigned*)(nb_ + (j < 6 ? j * 8192 : 49152)), 16, 0, 0); } while (0)
#define G2_LOADU(UR, N) do { if (wave < 2) { int lu_ = lane; asm volatile("" : "+v"(lu_)); const size_t it8_ = (size_t)(b * 32 + (N)) * 8 + h; _Pragma("unroll") for (int tt = 0; tt < 4; ++tt) UR[tt] = *(const u32x2*)(ws + WS_U + it8_ * 16384 + (size_t)(((et * 4 + tt) * 64) + lu_) * 8); } } while (0)
    G2_DMA(0); G2_LOADU(uA, 0);
    asm volatile("s_waitcnt vmcnt(0)" ::: "memory");
    __syncthreads();
    for (int n = 0; n < 32; n += 2) {
#pragma unroll
        for (int half = 0; half < 2; ++half) {
            const int N_ = n + half;
            if (N_ + 1 < 32) G2_DMA(N_ + 1);
            u32x2 (&UC_)[4] = uA;
            const float eg = GL[(size_t)(b * 32 + N_) * 8 + h];
        if (wave < 2) {
                int lq_ = lane; asm volatile("" : "+v"(lq_));
                const int i16 = lq_ & 15, g = lq_ >> 4;
                const unsigned char* B = lds + (N_ & 1) * STG;
                bf16x8 sf[4];
    #pragma unroll
                for (int ks = 0; ks < 4; ++ks) { const u32x4 w = pg8::pk8(S[2 * ks], S[2 * ks + 1]); sf[ks] = __builtin_bit_cast(bf16x8, w); }
                const unsigned char* Bl = B + lq_ * 16;
                bf16x8 fA[8], fB[8];
                f32x4 accA[4], accC[4];
#pragma unroll
                for (int tt = 0; tt < 4; ++tt) { accA[tt] = (f32x4){0.f, 0.f, 0.f, 0.f}; accC[tt] = (f32x4){0.f, 0.f, 0.f, 0.f}; }
#define G2_SCHED __builtin_amdgcn_sched_barrier(0)
#define G2_LD1(F, ks) do { _Pragma("unroll") for (int tt = 0; tt < 4; ++tt) { F[tt] = *(const bf16x8*)(Bl + ((tt * 4 + (ks)) * 64) * 16); F[4 + tt] = *(const bf16x8*)(Bl + 16384 + ((tt * 4 + (ks)) * 64) * 16); } } while (0)
#define G2_MM1(F, ks) do { _Pragma("unroll") for (int tt = 0; tt < 4; ++tt) { accA[tt] = __builtin_amdgcn_mfma_f32_16x16x32_bf16(F[tt], sf[ks], accA[tt], 0, 0, 0); accC[tt] = __builtin_amdgcn_mfma_f32_16x16x32_bf16(F[4 + tt], sf[ks], accC[tt], 0, 0, 0); } } while (0)
#define G2_LDK(F, k2) do { _Pragma("unroll") for (int dt = 0; dt < 8; ++dt) F[dt] = *(const bf16x8*)(Bl + 32768 + ((dt * 2 + (k2)) * 64) * 16); } while (0)
#define G2_MMK(F, k2) do { _Pragma("unroll") for (int dt = 0; dt < 8; ++dt) S[dt] = __builtin_amdgcn_mfma_f32_16x16x32_bf16(F[dt], vf[k2], S[dt], 0, 0, 0); } while (0)
#define G2_LDQ(F) do { _Pragma("unroll") for (int k2 = 0; k2 < 2; ++k2) _Pragma("unroll") for (int tt = 0; tt < 4; ++tt) F[k2 * 4 + tt] = *(const bf16x8*)(Bl + 49152 + ((tt * 2 + k2) * 64) * 16); } while (0)
#define G2_MMQ(F) do { _Pragma("unroll") for (int k2 = 0; k2 < 2; ++k2) _Pragma("unroll") for (int tt = 0; tt < 4; ++tt) accC[tt] = __builtin_amdgcn_mfma_f32_16x16x32_bf16(F[k2 * 4 + tt], vf[k2], accC[tt], 0, 0, 0); } while (0)
                G2_LD1(fA, 0); G2_SCHED;
                G2_LD1(fB, 1); G2_SCHED; G2_MM1(fA, 0); G2_SCHED;
                G2_LD1(fA, 2); G2_SCHED; G2_MM1(fB, 1); G2_SCHED;
                G2_LD1(fB, 3); G2_SCHED; G2_MM1(fA, 2); G2_SCHED;
                G2_LDK(fA, 0); G2_SCHED; G2_MM1(fB, 3); G2_SCHED;
                f32x4 vn[4];
#pragma unroll
                for (int tt = 0; tt < 4; ++tt) vn[tt] = (f32x4){lo16(UC_[tt].x), hi16(UC_[tt].x), lo16(UC_[tt].y), hi16(UC_[tt].y)} - accA[tt];
                bf16x8 vf[2];
#pragma unroll
                for (int k2 = 0; k2 < 2; ++k2) { const u32x4 w = pg8::pk8(vn[2 * k2], vn[2 * k2 + 1]); vf[k2] = __builtin_bit_cast(bf16x8, w); }
#pragma unroll
                for (int dt = 0; dt < 8; ++dt) S[dt] = S[dt] * eg;
                G2_SCHED;
                G2_LDK(fB, 1); G2_SCHED; G2_MMK(fA, 0); G2_SCHED;
                G2_LDQ(fA);    G2_SCHED; G2_MMK(fB, 1); G2_SCHED;
                G2_MMQ(fA); G2_SCHED;
#undef G2_SCHED
#undef G2_LD1
#undef G2_MM1
#undef G2_LDK
#undef G2_MMK
#undef G2_LDQ
#undef G2_MMQ
#pragma unroll
                for (int tt = 0; tt < 4; ++tt) {
                    const unsigned w01 = pk2(accC[tt][0], accC[tt][1]), w23 = pk2(accC[tt][2], accC[tt][3]);
                    bf16* op = ORAW + (size_t)((b * 32 + N_) * 64 + 16 * tt + 4 * g) * 1024 + h * 128 + 16 * et + i16;
                    op[0] = (bf16)(w01 & 0xffffu); op[1024] = (bf16)(w01 >> 16); op[2048] = (bf16)(w23 & 0xffffu); op[3072] = (bf16)(w23 >> 16);
                }
            }

            if (N_ + 1 < 32) G2_LOADU(uA, N_ + 1);
            asm volatile("s_waitcnt vmcnt(0)" ::: "memory");
            __syncthreads();
        }
    }
#undef G2_SRC
#undef G2_DMA
#undef G2_LOADU
}

template <bool dry> __device__ __forceinline__ void attn_unit(const Args& a, unsigned char* lds, int b, int h, int qb, int tid, int lane, int wave, float lam) {
    unsigned char* ws = a.ws;
    const bf16* DQ = (const bf16*)(ws + WS_DQ); const bf16* DK = (const bf16*)(ws + WS_DK); const bf16* DVT = (const bf16*)(ws + WS_DVT);
    const int i16 = lane & 15, g = lane >> 4;
    const int q0 = qb * 128 + wave * 16, qpos = q0 + i16;
    const size_t row = (size_t)b * SEQ + qpos;
    bf16x8 qf[2][2];
#pragma unroll
    for (int c = 0; c < 2; ++c)
#pragma unroll
        for (int ks = 0; ks < 2; ++ks) qf[c][ks] = *(const bf16x8*)(DQ + row * 1024 + h * 128 + c * 64 + ks * 32 + g * 8);
    f32x4 O[2][8];
#pragma unroll
    for (int c = 0; c < 2; ++c)
#pragma unroll
        for (int dt = 0; dt < 8; ++dt) O[c][dt] = (f32x4){0.f, 0.f, 0.f, 0.f};
    float mrun[2] = {-1e30f, -1e30f}, lrun[2] = {0.f, 0.f};
    const int nkt = 2 * qb + 2;
    const int rd0 = (g * 16 + (i16 ^ (2 * g))) * 16, rd1 = (g * 16 + (i16 ^ (2 * g) ^ 1)) * 16;
    const bf16* ksrc[2]; const bf16* vsrc[2]; int kdst[2], vdst[2];
#pragma unroll
    for (int j = 0; j < 2; ++j) {
        const int ck = tid + j * 512, key = ck >> 4, x = ck & 15, c = x >> 3, ks = (x >> 2) & 1, gg = x & 3;
        const int s = key >> 5, kk = key & 31, g2 = kk >> 3, xx = kk & 7, it = 2 * s + (xx >> 2), ii = 4 * g2 + (xx & 3);
        ksrc[j] = DK + ((size_t)b * SEQ + key) * 1024 + h * 128 + x * 8;
        kdst[j] = ((((it * 2 + c) * 2 + ks) * 64) + gg * 16 + (ii ^ (2 * gg) ^ ks)) * 16;
        const int d = ck >> 3, xv = ck & 7, sv = xv >> 2, gv = xv & 3;
        vsrc[j] = DVT + (size_t)(h * 128 + d) * M + (size_t)b * SEQ + xv * 8;
        vdst[j] = 16384 + ((((d >> 4) * 2 + sv) * 64) + gv * 16 + ((d & 15) ^ (2 * gv) ^ sv)) * 16;
    }
    u32x4 pre[4];
    pre[0] = *(const u32x4*)(ksrc[0]); pre[1] = *(const u32x4*)(ksrc[1]); pre[2] = *(const u32x4*)(vsrc[0]); pre[3] = *(const u32x4*)(vsrc[1]);
    *(u32x4*)(lds + kdst[0]) = pre[0]; *(u32x4*)(lds + kdst[1]) = pre[1]; *(u32x4*)(lds + vdst[0]) = pre[2]; *(u32x4*)(lds + vdst[1]) = pre[3];
    __syncthreads();
    for (int kt = 0; kt < nkt; ++kt) {
        const bool more = (kt + 1 < nkt);
        if (more) { const size_t ko = (size_t)(kt + 1) * 64 * 1024, vo = (size_t)(kt + 1) * 64;
            pre[0] = *(const u32x4*)(ksrc[0] + ko); pre[1] = *(const u32x4*)(ksrc[1] + ko); pre[2] = *(const u32x4*)(vsrc[0] + vo); pre[3] = *(const u32x4*)(vsrc[1] + vo); }
        if (kt * 64 <= q0 + 15) {
            const unsigned char* Kb = lds + (kt & 1) * 32768; const unsigned char* Vb = Kb + 16384;
            const bool need_mask = (kt * 64 + 63 > q0);
            bf16x8 fA[4], fB[4], pf[2][2];
            f32x4 st[4];
#define AT_SCHED __builtin_amdgcn_sched_barrier(0)
#define AT_LDK(F, c, ih) do { _Pragma("unroll") for (int i2 = 0; i2 < 2; ++i2) _Pragma("unroll") for (int ks = 0; ks < 2; ++ks) F[i2 * 2 + ks] = *(const bf16x8*)(Kb + ((((2 * (ih) + i2) * 2 + (c)) * 2 + ks) * 64) * 16 + (ks ? rd1 : rd0)); } while (0)
#define AT_LDV(F, sx, dh) do { _Pragma("unroll") for (int d2 = 0; d2 < 4; ++d2) F[d2] = *(const bf16x8*)(Vb + (((4 * (dh) + d2) * 2 + (sx)) * 64) * 16 + ((sx) ? rd1 : rd0)); } while (0)
#define AT_QK(F, c, ih) do { _Pragma("unroll") for (int i2 = 0; i2 < 2; ++i2) st[2 * (ih) + i2] = (f32x4){0.f, 0.f, 0.f, 0.f}; _Pragma("unroll") for (int ks = 0; ks < 2; ++ks) _Pragma("unroll") for (int i2 = 0; i2 < 2; ++i2) st[2 * (ih) + i2] = __builtin_amdgcn_mfma_f32_16x16x32_bf16(F[i2 * 2 + ks], qf[c][ks], st[2 * (ih) + i2], 0, 0, 0); } while (0)
#define AT_PV(F, sx, dh) do { _Pragma("unroll") for (int d2 = 0; d2 < 4; ++d2) { O[0][4 * (dh) + d2] = __builtin_amdgcn_mfma_f32_16x16x32_bf16(F[d2], pf[0][sx], O[0][4 * (dh) + d2], 0, 0, 0); O[1][4 * (dh) + d2] = __builtin_amdgcn_mfma_f32_16x16x32_bf16(F[d2], pf[1][sx], O[1][4 * (dh) + d2], 0, 0, 0); } } while (0)
#define AT_SOFTMAX(c) do { \
                float mx = -1e30f; \
                _Pragma("unroll") for (int it = 0; it < 4; ++it) _Pragma("unroll") for (int r = 0; r < 4; ++r) { float v = st[it][r]; \
                    if (need_mask) { const int key = kt * 64 + 32 * (it >> 1) + 8 * g + 4 * (it & 1) + r; if (key > qpos) v = -1e30f; } \
                    st[it][r] = v; mx = fmaxf(mx, v); } \
                mx = fmaxf(mx, __shfl_xor(mx, 16)); mx = fmaxf(mx, __shfl_xor(mx, 32)); \
                const float mn = fmaxf(mrun[c], mx), al = __builtin_amdgcn_exp2f(mrun[c] - mn); \
                mrun[c] = mn; \
                float psum = 0.f; \
                _Pragma("unroll") for (int it = 0; it < 4; ++it) _Pragma("unroll") for (int r = 0; r < 4; ++r) { const float pp = __builtin_amdgcn_exp2f(st[it][r] - mn); psum += pp; st[it][r] = pp; } \
                lrun[c] = lrun[c] * al + psum; \
                if (__builtin_amdgcn_ballot_w64(al != 1.0f)) { _Pragma("unroll") for (int dt = 0; dt < 8; ++dt) O[c][dt] = O[c][dt] * al; } \
                _Pragma("unroll") for (int sx = 0; sx < 2; ++sx) { const u32x4 w = pg8::pk8(st[2 * sx], st[2 * sx + 1]); pf[c][sx] = __builtin_bit_cast(bf16x8, w); } \
            } while (0)
            AT_LDK(fA, 0, 0); AT_SCHED;
            AT_LDK(fB, 0, 1); AT_SCHED; AT_QK(fA, 0, 0); AT_SCHED;
            AT_LDK(fA, 1, 0); AT_SCHED; AT_QK(fB, 0, 1); AT_SCHED;
            AT_SOFTMAX(0); AT_SCHED;
            AT_LDK(fB, 1, 1); AT_SCHED; AT_QK(fA, 1, 0); AT_SCHED;
            AT_LDV(fA, 0, 0); AT_SCHED; AT_QK(fB, 1, 1); AT_SCHED;
            AT_SOFTMAX(1); AT_SCHED;
            AT_LDV(fB, 0, 1); AT_SCHED; AT_PV(fA, 0, 0); AT_SCHED;
            AT_LDV(fA, 1, 0); AT_SCHED; AT_PV(fB, 0, 1); AT_SCHED;
            AT_LDV(fB, 1, 1); AT_SCHED; AT_PV(fA, 1, 0); AT_SCHED;
            AT_PV(fB, 1, 1); AT_SCHED;
#undef AT_SCHED
#undef AT_LDK
#undef AT_LDV
#undef AT_QK
#undef AT_PV
#undef AT_SOFTMAX
        }
        if (more) { unsigned char* nb = lds + ((kt + 1) & 1) * 32768;
            *(u32x4*)(nb + kdst[0]) = pre[0]; *(u32x4*)(nb + kdst[1]) = pre[1]; *(u32x4*)(nb + vdst[0]) = pre[2]; *(u32x4*)(nb + vdst[1]) = pre[3]; }
        __syncthreads();
    }
    float l0 = lrun[0], l1 = lrun[1];
    l0 += __shfl_xor(l0, 16); l0 += __shfl_xor(l0, 32); l1 += __shfl_xor(l1, 16); l1 += __shfl_xor(l1, 32);
    const float il0 = __builtin_amdgcn_rcpf(l0), il1 = lam * __builtin_amdgcn_rcpf(l1);
    const bf16* ORAW = (const bf16*)a.out + (size_t)M * DM;
    bf16* GZ = (bf16*)(ws + WS_GZ); const bf16* GA = (const bf16*)(ws + WS_GA); const bf16* GB = (const bf16*)(ws + WS_GB);
    float ssb = 0.f, ssa = 0.f;
    u32x2 oaw[8];
#pragma unroll
    for (int dt = 0; dt < 8; ++dt) {
        O[0][dt] = O[0][dt] * il0 - O[1][dt] * il1;
        ssb += (O[0][dt][0] * O[0][dt][0] + O[0][dt][1] * O[0][dt][1]) + (O[0][dt][2] * O[0][dt][2] + O[0][dt][3] * O[0][dt][3]);
        oaw[dt] = *(const u32x2*)(ORAW + row * 1024 + h * 128 + dt * 16 + g * 4);
        const float o0 = lo16(oaw[dt].x), o1 = hi16(oaw[dt].x), o2 = lo16(oaw[dt].y), o3 = hi16(oaw[dt].y);
        ssa += (o0 * o0 + o1 * o1) + (o2 * o2 + o3 * o3);
    }
    ssb += __shfl_xor(ssb, 16); ssb += __shfl_xor(ssb, 32); ssa += __shfl_xor(ssa, 16); ssa += __shfl_xor(ssa, 32);
    const float rb = __builtin_amdgcn_rsqf(ssb * (1.0f / 128.0f) + EPS) * (1.0f - LAMBDA_INIT), ra = __builtin_amdgcn_rsqf(ssa * (1.0f / 128.0f) + EPS);
#pragma unroll
    for (int dt = 0; dt < 8; ++dt) {
        const int d0 = dt * 16 + g * 4; const size_t off = row * 1024 + h * 128 + d0;
        const u32x2 zw = *(const u32x2*)(GZ + off), gaw = *(const u32x2*)(GA + off), gbw = *(const u32x2*)(GB + off);
        const f32x4 wsub = *(const f32x4*)(a.in[13] + d0), wgdn = *(const f32x4*)(a.in[6] + d0);
        const float zz[4] = {lo16(zw.x), hi16(zw.x), lo16(zw.y), hi16(zw.y)}, ga[4] = {lo16(gaw.x), hi16(gaw.x), lo16(gaw.y), hi16(gaw.y)}, gb[4] = {lo16(gbw.x), hi16(gbw.x), lo16(gbw.y), hi16(gbw.y)};
        const float oa[4] = {lo16(oaw[dt].x), hi16(oaw[dt].x), lo16(oaw[dt].y), hi16(oaw[dt].y)};
        float mv[4];
#pragma unroll
        for (int r = 0; r < 4; ++r) mv[r] = sigmoidf_(ga[r]) * (oa[r] * ra * wgdn[r] * siluf_(zz[r])) + sigmoidf_(gb[r]) * (O[0][dt][r] * rb * wsub[r]);
        u32x2 w; w.x = pk2(mv[0], mv[1]); w.y = pk2(mv[2], mv[3]);
        if (!dry) *(u32x2*)(GZ + off) = w;
    }
}

typedef __attribute__((address_space(1))) unsigned gu32;
#define RLX_AGENT __ATOMIC_RELAXED, __HIP_MEMORY_SCOPE_AGENT
#define XB_TMO      128
#define XB_XCNT(j)  (256  + 64 * (j))
#define XB_XSUB(j)  (1280 + 64 * (j))
#define XB_XGEN(j)  (2304 + 64 * (j))
#define XB_TOP      3328
#define XB_TOPGEN   3392
#define XCD_BAR_WORDS 3456
#define XB_SPIN_CAP (1u << 18)

__device__ __forceinline__ unsigned xb_ld(unsigned* p)              { return __hip_atomic_load(p, __ATOMIC_RELAXED, __HIP_MEMORY_SCOPE_AGENT); }
__device__ __forceinline__ unsigned xb_add(unsigned* p, unsigned v) { return __hip_atomic_fetch_add(p, v, __ATOMIC_RELAXED, __HIP_MEMORY_SCOPE_AGENT); }
__device__ __forceinline__ unsigned xb_xcc_id() { return (unsigned)__builtin_amdgcn_s_getreg((3 << 11) | 20) & 0xFu; }
#define XB_SPIN(cond, bar) do { unsigned _sp = 0; while (cond) { __builtin_amdgcn_s_sleep(1); \
    if ((++_sp & 255u) == 0u) { if (xb_ld(&(bar)[XB_TMO])) break; if (_sp > XB_SPIN_CAP) { atomicAdd(&(bar)[XB_TMO], 1u); break; } } } } while (0)

struct XcdBarrier {
    unsigned* bar; unsigned x;
    volatile LAS unsigned* st;
};

__device__ __forceinline__ XcdBarrier xcd_barrier_post(unsigned* bar, volatile LAS unsigned* st) {
    XcdBarrier b; b.bar = bar; b.x = xb_xcc_id(); b.st = st;
    if (threadIdx.x == 0) (void)xb_add(&bar[XB_XCNT(b.x)], 1u);
    return b;
}
__device__ __forceinline__ void xcd_barrier_complete(unsigned* bar, unsigned x, unsigned& nloc, unsigned& nx) {
    const unsigned G = gridDim.x * gridDim.y * gridDim.z;
    unsigned sum, cnt, mine, sp = 0u;
    for (;;) {
        sum = 0u; cnt = 0u; mine = 0u;
#pragma unroll
        for (unsigned j = 0; j < 16; ++j) { const unsigned c = xb_ld(&bar[XB_XCNT(j)]); sum += c; cnt += (c > 0u) ? 1u : 0u; mine = (j == x) ? c : mine; }
        if (sum == G) break;
        __builtin_amdgcn_s_sleep(1);
        if ((++sp & 255u) == 0u) { if (xb_ld(&bar[XB_TMO])) break; if (sp > XB_SPIN_CAP) { atomicAdd(&bar[XB_TMO], 1u); break; } }
    }
    nloc = mine > 0u ? mine : 1u; nx = cnt > 0u ? cnt : 1u;
}

__device__ __forceinline__ void xcd_barrier(const XcdBarrier& b, int wave_s) {
    asm volatile("s_waitcnt vmcnt(0)" ::: "memory");
    __syncthreads();
    if (wave_s == 0 && __builtin_amdgcn_mbcnt_hi(~0u, __builtin_amdgcn_mbcnt_lo(~0u, 0u)) == 0u) {
        unsigned* bar = b.bar;
        __builtin_amdgcn_s_waitcnt(0);
        unsigned nloc = b.st[0], nx = b.st[1];
        if (nloc == 0u) { xcd_barrier_complete(bar, b.x, nloc, nx); b.st[0] = nloc; b.st[1] = nx; }
        const unsigned old = xb_add(&bar[XB_XSUB(b.x)], 1u);
        const unsigned gen = old / nloc;
        if (old + 1u == (gen + 1u) * nloc) {
            __builtin_amdgcn_fence(__ATOMIC_RELEASE, "agent");
            asm volatile("s_waitcnt vmcnt(0)" ::: "memory");
            const unsigned og = xb_add(&bar[XB_TOP], 1u);
            const unsigned tg = og / nx;
            if (og + 1u == (tg + 1u) * nx) xb_add(&bar[XB_TOPGEN], 1u);
            else XB_SPIN(xb_ld(&bar[XB_TOPGEN]) == tg, bar);
            __builtin_amdgcn_fence(__ATOMIC_ACQUIRE, "agent");
            xb_add(&bar[XB_XGEN(b.x)], 1u);
            asm volatile("s_waitcnt vmcnt(0)" ::: "memory");
        } else {
            XB_SPIN(xb_ld(&bar[XB_XGEN(b.x)]) == gen, bar);
            __builtin_amdgcn_fence(__ATOMIC_ACQUIRE, "agent");
            asm volatile("s_waitcnt vmcnt(0)" ::: "memory");
        }
    }
    __syncthreads();
}


__global__ void __launch_bounds__(512, 2) fwd_kernel(Args a) {
    extern __shared__ __attribute__((aligned(16))) unsigned char lds[];
    cg::grid_group grid = cg::this_grid();
    const int G = gridDim.x, bx = blockIdx.x;
    volatile LAS unsigned* bst = (volatile LAS unsigned*)((LAS unsigned char*)lds + (LDS_BYTES - 64));
    if (threadIdx.x < 2) bst[threadIdx.x] = 0u;
    __syncthreads();
    const XcdBarrier gbar = xcd_barrier_post((unsigned*)a.ws, bst);
    if (a.ph_hi == 0x7fffffff) grid.sync();
    const int wave_s = __builtin_amdgcn_readfirstlane((int)threadIdx.x >> 6);
#define PHASE_IDS int tid = wave_s * 64 + (int)__builtin_amdgcn_mbcnt_hi(~0u, __builtin_amdgcn_mbcnt_lo(~0u, 0u)); asm volatile("" : "+v"(tid)); const int lane = tid & 63, wave = __builtin_amdgcn_readfirstlane(tid >> 6); (void)lane; (void)wave;
    const int vcu = (G % 8 == 0) ? (bx % 8) * (G / 8) + bx / 8 : bx;
    unsigned char* ws = a.ws;
    LAS unsigned char* ldsl = (LAS unsigned char*)lds;
    const int lo = a.ph_lo, hi = a.ph_hi;
#define IN(k) (lo <= (k) && (k) < hi)
#define SEAM(k) do { if (IN(k) && IN((k) + 1)) xcd_barrier(gbar, wave_s); } while (0)
    bf16* XN = (bf16*)a.out;
    bf16* WIN = (bf16*)(ws + WS_WIN);

    _Pragma("unroll") for (int rp = 0; rp < REP_P0; ++rp) { if (rp) xcd_barrier(gbar, wave_s); if (IN(0)) { PHASE_IDS p0_prologue(a, lds, tid, lane, wave, vcu, G); } }
    SEAM(0);
    _Pragma("unroll") for (int rp = 0; rp < REP_P1G1; ++rp) {
    if (rp) xcd_barrier(gbar, wave_s);
    _Pragma("unroll") for (int rp1 = 0; rp1 < REP_P1; ++rp1) {
    if (rp1) xcd_barrier(gbar, wave_s);
    if (IN(1)) {
        pg8::Gemm g{XN, WIN, M, 3072, 1024}; pg8::StaticOrder S; S.init(M, 3072, G, bx);
        pg8::EpiProj E{(bf16*)(ws + WS_TQ), (bf16*)(ws + WS_TK), (bf16*)(ws + WS_TV), nullptr, nullptr, 7u, (bf16*)(ws + WS_HALO), 0u, nullptr, nullptr, 0};
        pg8::gemm_phase<pg8::EpiProj, pg8::StaticOrder, true, true>(ldsl, g, S, E, wave_s);
    }
    }
    SEAM(1);
    if (IN(2)) { PHASE_IDS u32x4 raw[11]; if (bx < 2048) g1_load_raw(a, bx, tid, raw);
        for (int it = bx; it < 2048; it += G) g1_item(a, lds, it, (it + G < 2048) ? it + G : -1, raw, tid, lane, wave); }
    }
    SEAM(2);
    _Pragma("unroll") for (int rp = 0; rp < REP_G2; ++rp) { if (rp) xcd_barrier(gbar, wave_s); if (IN(3)) { PHASE_IDS for (int it = bx; it < 256; it += G) { const int it2 = (G == 256) ? (((it & 7) * 8 + (it >> 5)) * 4 + ((it >> 3) & 3)) : it;
            g2_item(a, lds, it2, tid, lane, wave); } } }
    SEAM(3);
    _Pragma("unroll") for (int rp = 0; rp < REP_P4; ++rp) {
    if (rp) xcd_barrier(gbar, wave_s);
    if (IN(4)) {
        { pg8::Gemm g{XN, WIN + (size_t)3072 * 1024, M, 5120, 1024}; pg8::StaticOrder S; S.init(M, 5120, G, bx);
          pg8::EpiProj E{(bf16*)(ws + WS_GZ), (bf16*)(ws + WS_GA), (bf16*)(ws + WS_DQ), (bf16*)(ws + WS_DK), (bf16*)(ws + WS_GB), 0u, nullptr, 12u, a.in[7], a.in[8], 2};
          pg8::gemm_phase<pg8::EpiProj, pg8::StaticOrder, true, true>(ldsl, g, S, E, wave_s); }
        { pg8::Gemm g{WIN + (size_t)8192 * 1024, XN, 1024, M, 1024}; pg8::StaticOrder S; S.init(1024, M, G, bx);
          pg8::EpiPlain E{(bf16*)(ws + WS_DVT), M};
          pg8::gemm_phase<pg8::EpiPlain, pg8::StaticOrder, true, true>(ldsl, g, S, E, wave_s); }
    }
    }
    SEAM(4);
    if (IN(5)) {
        PHASE_IDS
        float s1 = 0.f, s2 = 0.f;
        for (int d = 0; d < 64; ++d) { s1 += a.in[9][d] * a.in[10][d]; s2 += a.in[11][d] * a.in[12][d]; }
        const float lam = expf(s1) - expf(s2) + LAMBDA_INIT;
#if REP_ATT > 1
        for (int rp = 1; rp < REP_ATT; ++rp) {
            for (int p = bx; p < 512; p += G) { const int bh = p >> 3, j = p & 7; attn_unit<true>(a, lds, bh >> 3, bh & 7, 15 - j, tid, lane, wave, lam); attn_unit<true>(a, lds, bh >> 3, bh & 7, j, tid, lane, wave, lam); }
            xcd_barrier(gbar, wave_s);
        }
#endif
        for (int p0 = bx; p0 < 512; p0 += G) { const int p = (G == 256) ? ((((p0 & 7) * 8 + ((p0 >> 6) & 3) + 4 * (p0 >> 8)) << 3) | ((p0 >> 3) & 7)) : p0;
            const int bh = p >> 3, j = p & 7; attn_unit<false>(a, lds, bh >> 3, bh & 7, 15 - j, tid, lane, wave, lam); attn_unit<false>(a, lds, bh >> 3, bh & 7, j, tid, lane, wave, lam); }
    }
    SEAM(5);
    _Pragma("unroll") for (int rs = 0; rs < REP_SYNC; ++rs) xcd_barrier(gbar, wave_s);
    _Pragma("unroll") for (int rp6 = 0; rp6 < REP_P6; ++rp6) {
    if (rp6) xcd_barrier(gbar, wave_s);
    if (IN(6)) {
        pg8::Gemm g{(bf16*)(ws + WS_GZ), (bf16*)(ws + WS_WOUT), M, 1024, 1024}; pg8::StaticOrder S; S.init(M, 1024, G, bx);
        pg8::EpiOut E{a.in[0], a.out, (bf16*)(ws + WS_H1B), (float*)(ws + WS_RSS)};
        pg8::gemm_phase<pg8::EpiOut, pg8::StaticOrder, true, true>(ldsl, g, S, E, wave_s);
    }
    }
    SEAM(6);
    _Pragma("unroll") for (int rp = 0; rp < REP_P7; ++rp) {
    if (rp) xcd_barrier(gbar, wave_s);
    if (IN(7)) {
        pg8::Gemm g{(bf16*)(ws + WS_H1B), (bf16*)(ws + WS_WGU), M, 2 * FF, 1024}; pg8::StaticOrder S; S.init(M, 2 * FF, G, bx);
        pg8::EpiSwiGLU E{(const float*)(ws + WS_RSS), (bf16*)(ws + WS_HFF), FF};
        pg8::gemm_phase<pg8::EpiSwiGLU, pg8::StaticOrder, true, true>(ldsl, g, S, E, wave_s);
    }
    }
    SEAM(7);
    _Pragma("unroll") for (int rp8 = 0; rp8 < REP_P8; ++rp8) {
    if (rp8) xcd_barrier(gbar, wave_s);
    if (IN(8)) {
        pg8::Gemm g{(bf16*)(ws + WS_HFF), (bf16*)(ws + WS_WD), M, 1024, FF}; pg8::StaticOrder S; S.init(M, 1024, G, bx);
        pg8::EpiDown E{a.out, (rp8 + 1 < REP_P8) ? (float)a.ph_lo : 1.0f, (const bf16*)(ws + WS_H1B)};
        pg8::gemm_phase<pg8::EpiDown, pg8::StaticOrder, true, true>(ldsl, g, S, E, wave_s);
    }
    }
#undef IN
#undef SEAM
}

extern "C" void kernel_launch(void* const* d_in, const int* in_sizes, int n_in, void* d_out, int out_size, void* d_ws, size_t ws_size, hipStream_t stream) {
    static int grid = 0;
    if (grid == 0) {
        if (n_in != 19 || out_size != M * DM || ws_size < WS_NEED) { fprintf(stderr, "kernel_launch: unexpected problem shape (n_in %d out %d ws %zu)\n", n_in, out_size, ws_size); grid = -1; return; }
        int dev = 0, cus = 0, per_cu = 0;
        hipGetDevice(&dev); hipDeviceGetAttribute(&cus, hipDeviceAttributeMultiprocessorCount, dev);
        hipFuncSetAttribute((const void*)fwd_kernel, hipFuncAttributeMaxDynamicSharedMemorySize, LDS_BYTES);
        hipOccupancyMaxActiveBlocksPerMultiprocessor(&per_cu, (const void*)fwd_kernel, 512, LDS_BYTES);
        if (per_cu < 1) per_cu = 1;
        grid = cus * per_cu;
        (void)hipGetLastError();
    }
    if (grid < 0) return;
    if (hipMemsetAsync(d_ws, 0, 65536, stream) != hipSuccess) { fprintf(stderr, "kernel_launch: memset of the barrier words failed\n"); return; }
    Args a{};
    for (int i = 0; i < 19; ++i) a.in[i] = (const float*)d_in[i];
    a.out = (float*)d_out; a.ws = (unsigned char*)d_ws; a.ph_lo = 0; a.ph_hi = 9;
    void* args[] = {&a};
    hipError_t e = hipLaunchCooperativeKernel((const void*)fwd_kernel, dim3(grid), dim3(512), args, LDS_BYTES, stream);
    if (e != hipSuccess) fprintf(stderr, "cooperative launch failed: %s (grid %d)\n", hipGetErrorString(e), grid);
}
```

```cpp
#include <hip/hip_runtime.h>
#include <hip/hip_cooperative_groups.h>
#include <cstdio>
#include <cstdint>
namespace cg = cooperative_groups;
namespace pg8 {
#define PG8_LAS __attribute__((address_space(3)))
typedef unsigned short bf16_t;
typedef short bf16x8 __attribute__((ext_vector_type(8)));
typedef float f32x4 __attribute__((ext_vector_type(4)));
typedef unsigned u32x4 __attribute__((ext_vector_type(4)));
constexpr int BM = 256, BK = 64, HALF = 128, HTB = HALF * BK * 2  , STAGE_BYTES = 8 * HTB, NXCD = 8, WGM = 4;

__host__ __device__ __forceinline__ int lds_byte(int r, int c) { const int st = (r >> 4) * 2 + (c >> 5), rr = r & 15, cc = c & 31, ob = rr * 64 + cc * 2; return st * 1024 + (ob ^ (((ob >> 9) & 1) << 5)); }
__host__ __device__ __forceinline__ void stage_rc(int b, int& R, int& C) { const int st = b / 1024, sb = b % 1024, swz = sb ^ (((sb >> 9) & 1) << 5); R = (st >> 1) * 16 + swz / 64; C = (st & 1) * 32 + (swz % 64) / 2; }
__host__ __device__ __forceinline__ int perm32(int rho) { const int n = rho >> 4, i = rho & 15; return 8 * (i >> 2) + 4 * n + (i & 3); }

struct Unit { int pm, pn; };
struct Gemm { const bf16_t* A; const bf16_t* Bt; int M, N, K; };

struct StaticOrder {
    int nM, nN, nwg, G, c;
    __host__ __device__ void init(int M, int N, int G_, int c_) { nM = M / BM; nN = N / BM; nwg = nM * nN; G = G_; c = c_; }
    __host__ __device__ bool next(int i, Unit& u) const {
        const long L = (long)i * G + c; if (L >= nwg) return false;
        int wgid = (int)L; { const int q = nwg / NXCD, r = nwg % NXCD, xcd = wgid % NXCD, off = wgid / NXCD; wgid = (xcd < r ? xcd * (q + 1) : r * (q + 1) + (xcd - r) * q) + off; }
        const int nig = WGM * nN, gid = wgid / nig, fm = gid * WGM, gsz = (nM - fm) < WGM ? (nM - fm) : WGM;
        u.pm = fm + ((wgid % nig) % gsz); u.pn = (wgid % nig) / gsz; return true;
    }
    __device__ __forceinline__ void a_ready(const Unit&) const {}
    __device__ __forceinline__ void done(const Unit&) const {}
};
__device__ __forceinline__ unsigned cvt_pk_bf16(float lo, float hi) { unsigned r; asm volatile("v_cvt_pk_bf16_f32 %0, %1, %2" : "=v"(r) : "v"(lo), "v"(hi)); return r; }
typedef float f32x2v __attribute__((ext_vector_type(2)));
typedef __bf16 bf16x2v __attribute__((ext_vector_type(2)));
__device__ __forceinline__ unsigned pk_bf16(float lo, float hi) { f32x2v v = {lo, hi}; bf16x2v b = __builtin_convertvector(v, bf16x2v); return __builtin_bit_cast(unsigned, b); }
__device__ __forceinline__ u32x4 pk8(const f32x4& a, const f32x4& b) { u32x4 w; w.x = pk_bf16(a[0], a[1]); w.y = pk_bf16(a[2], a[3]); w.z = pk_bf16(b[0], b[1]); w.w = pk_bf16(b[2], b[3]); return w; }

struct EpiProj {
    static constexpr bool PERM = true, AFTER_DRAIN = false;
    bf16_t *o0, *o1, *o2, *o3, *o4; unsigned tile_mask; bf16_t* halo; unsigned norm_mask; const float *nw0, *nw1; int norm_q;
    __device__ __forceinline__ void operator()(const f32x4 (&acc)[2][2][4][2], const Unit& u, int wr, int wc, int fr, int fq) const {
        const int t = u.pn >> 2, c0 = (u.pn & 3) * 256 + wc * 32 + 8 * fq;
        bf16_t* base = t == 0 ? o0 : t == 1 ? o1 : t == 2 ? o2 : t == 3 ? o3 : o4;
        const bool tiled = (tile_mask >> t) & 1u;
        if ((norm_mask >> t) & 1u) {
            const float* nw = t == norm_q ? nw0 : nw1; const float sc = t == norm_q ? 0.125f * 1.4426950408889634f : 1.0f;
#pragma unroll
            for (int ai = 0; ai < 2; ++ai)
#pragma unroll
                for (int m = 0; m < 4; ++m) {
                    const int row = u.pm * BM + ai * HALF + wr * 64 + m * 16 + fr;
                    float ss = 0.f;
#pragma unroll
                    for (int bj = 0; bj < 2; ++bj)
#pragma unroll
                        for (int n = 0; n < 2; ++n) { const f32x4 v = acc[ai][bj][m][n]; ss += (v[0] * v[0] + v[1] * v[1]) + (v[2] * v[2] + v[3] * v[3]); }
                    ss += __shfl_xor(ss, 16); ss += __shfl_xor(ss, 32);
                    const float r = __builtin_amdgcn_rsqf(ss * (1.0f / 64.0f) + 1e-6f) * sc;
#pragma unroll
                    for (int bj = 0; bj < 2; ++bj) {
                        const int col = ((u.pn & 3) * 4 + wc) * 64 + 32 * bj + 8 * fq;
                        const f32x4 w0 = *(const f32x4*)(nw + 32 * bj + 8 * fq), w1 = *(const f32x4*)(nw + 32 * bj + 8 * fq + 4);
                        *(u32x4*)(base + (size_t)row * 1024 + col) = pk8(acc[ai][bj][m][0] * r * w0, acc[ai][bj][m][1] * r * w1);
                    }
                }
            return;
        }
#pragma unroll
        for (int ai = 0; ai < 2; ++ai)
#pragma unroll
            for (int m = 0; m < 4; ++m) {
                const int row = u.pm * BM + ai * HALF + wr * 64 + m * 16 + fr;
#pragma unroll
                for (int bj = 0; bj < 2; ++bj) {
                    const int col = c0 + bj * HALF;
                    const u32x4 w = pk8(acc[ai][bj][m][0], acc[ai][bj][m][1]);
                    if (tiled) {
                        const int h = col >> 7, d = col & 127, chunk = row >> 6, tok = row & 63;
                        *(u32x4*)(base + ((size_t)(chunk * 8 + h) * 64 + tok) * 128 + d) = w;
                        if (tok >= 61) *(u32x4*)(halo + (((size_t)(chunk * 8 + h) * 3 + t) * 3 + (tok - 61)) * 128 + d) = w;
                    } else {
                        *(u32x4*)(base + (size_t)row * 1024 + col) = w;
                    }
                }
            }
    }
};
struct EpiPlain {
    static constexpr bool PERM = true, AFTER_DRAIN = false;
    bf16_t* O; int ldc;
    __device__ __forceinline__ void operator()(const f32x4 (&acc)[2][2][4][2], const Unit& u, int wr, int wc, int fr, int fq) const {
#pragma unroll
        for (int ai = 0; ai < 2; ++ai)
#pragma unroll
            for (int m = 0; m < 4; ++m) {
                const int row = u.pm * BM + ai * HALF + wr * 64 + m * 16 + fr;
#pragma unroll
                for (int bj = 0; bj < 2; ++bj) {
                    const int col = u.pn * BM + bj * HALF + wc * 32 + 8 * fq;
                    *(u32x4*)(O + (size_t)row * ldc + col) = pk8(acc[ai][bj][m][0], acc[ai][bj][m][1]);
                }
            }
    }
};
struct EpiOut {
    static constexpr bool PERM = false, AFTER_DRAIN = false;
    const float* x; float* h1; bf16_t* h1b; float* rowss;
    __device__ __forceinline__ void operator()(const f32x4 (&acc)[2][2][4][2], const Unit& u, int wr, int wc, int fr, int fq) const {
#pragma unroll
        for (int ai = 0; ai < 2; ++ai)
#pragma unroll
            for (int m = 0; m < 4; ++m) {
                const int row = u.pm * BM + ai * HALF + wr * 64 + m * 16 + fr;
                float ss = 0.f;
#pragma unroll
                for (int bj = 0; bj < 2; ++bj)
#pragma unroll
                    for (int n = 0; n < 2; ++n) {
                        const int col = u.pn * BM + bj * HALF + wc * 32 + n * 16 + 4 * fq;
                        const size_t off = (size_t)row * 1024 + col;
                        const f32x4 v = *(const f32x4*)(x + off) + acc[ai][bj][m][n];
                        f32x2v pw; pw.x = __builtin_bit_cast(float, pk_bf16(v[0], v[1])); pw.y = __builtin_bit_cast(float, pk_bf16(v[2], v[3]));
                        *(f32x2v*)(h1b + off) = pw;
                        ss += (v[0] * v[0] + v[1] * v[1]) + (v[2] * v[2] + v[3] * v[3]);
                    }
                ss += __shfl_xor(ss, 16); ss += __shfl_xor(ss, 32);
                if (fq == 0) rowss[(size_t)row * 16 + u.pn * 4 + wc] = ss;
            }
    }
};
struct EpiSwiGLU {
    static constexpr bool PERM = true, AFTER_DRAIN = false;
    const float* rowss; bf16_t* hff; int ldh;
    __device__ __forceinline__ void operator()(const f32x4 (&acc)[2][2][4][2], const Unit& u, int wr, int wc, int fr, int fq) const {
#pragma unroll
        for (int ai = 0; ai < 2; ++ai)
#pragma unroll
            for (int m = 0; m < 4; ++m) {
                const int row = u.pm * BM + ai * HALF + wr * 64 + m * 16 + fr;
                const f32x4* rp = (const f32x4*)(rowss + (size_t)row * 16);
                const f32x4 p0 = rp[0], p1 = rp[1], p2 = rp[2], p3 = rp[3];
                const f32x4 ps = (p0 + p1) + (p2 + p3);
                const float rstd = __builtin_amdgcn_rsqf(((ps[0] + ps[1]) + (ps[2] + ps[3])) * (1.0f / 1024.0f) + 1e-6f);
                f32x4 hv[2];
#pragma unroll
                for (int n = 0; n < 2; ++n) {
                    const f32x4 g = acc[ai][0][m][n] * rstd, up = acc[ai][1][m][n] * rstd;
#pragma unroll
                    for (int e = 0; e < 4; ++e) hv[n][e] = g[e] * __builtin_amdgcn_rcpf(1.0f + __expf(-g[e])) * up[e];
                }
                *(u32x4*)(hff + (size_t)row * ldh + u.pn * 128 + wc * 32 + 8 * fq) = pk8(hv[0], hv[1]);
            }
    }
};
struct EpiDown {
    static constexpr bool PERM = false, AFTER_DRAIN = false;
    float* out; float sc; const bf16_t* h1b;
    __device__ __forceinline__ void operator()(const f32x4 (&acc)[2][2][4][2], const Unit& u, int wr, int wc, int fr, int fq) const {
#pragma unroll
        for (int ai = 0; ai < 2; ++ai)
#pragma unroll
            for (int m = 0; m < 4; ++m) {
                const int row = u.pm * BM + ai * HALF + wr * 64 + m * 16 + fr;
#pragma unroll
                for (int bj = 0; bj < 2; ++bj)
#pragma unroll
                    for (int n = 0; n < 2; ++n) {
                        const size_t off = (size_t)row * 1024 + u.pn * BM + bj * HALF + wc * 32 + n * 16 + 4 * fq;
                        typedef unsigned u32x2e __attribute__((ext_vector_type(2)));
                        const u32x2e hw = *(const u32x2e*)(h1b + off);
                        const f32x4 hv = {__uint_as_float(hw.x << 16), __uint_as_float(hw.x & 0xffff0000u), __uint_as_float(hw.y << 16), __uint_as_float(hw.y & 0xffff0000u)};
                        __builtin_nontemporal_store(hv + acc[ai][bj][m][n] * sc, (f32x4*)(out + off));
                    }
            }
    }
};

template <class Epi, class Sched, bool ALIGN_EPI = false, bool SP2 = false>
__device__ __forceinline__ void gemm_phase(PG8_LAS unsigned char* lds, const Gemm g, const Sched& S, const Epi& E, int wave_s) {
    int tid_o = wave_s * 64 + (int)__builtin_amdgcn_mbcnt_hi(~0u, __builtin_amdgcn_mbcnt_lo(~0u, 0u)); asm volatile("" : "+v"(tid_o));
    const int tid = tid_o, wid = __builtin_amdgcn_readfirstlane(tid >> 6), lane = tid & 63, wr = wid >> 2, wc = wid & 3, fr = lane & 15, fq = lane >> 4;
    const int K = g.K, nt = K / BK;
    unsigned voffA[2], voffB[2];
#pragma unroll
    for (int i = 0; i < 2; ++i) { int R, C; stage_rc(tid * 16 + i * 8192, R, C); const int Rb = Epi::PERM ? ((R & ~31) + perm32(R & 31)) : R;
        voffA[i] = (unsigned)(R * K + C) * 2u; voffB[i] = (unsigned)(Rb * K + C) * 2u; }
    const size_t kstep = (size_t)(BK * 2);
    const size_t hstep = (size_t)HALF * K * 2;
    const size_t tstep = 2 * hstep;
    const unsigned ldsw = (unsigned)wid * 1024u;
    const int aoff = lds_byte(wr * 64 + fr, fq * 8), boff = lds_byte(wc * 32 + fr, fq * 8);
#define PG8_SA(b, h) (((b) * 2 + (h)) * HTB)
#define PG8_SB(b, h) ((4 + (b) * 2 + (h)) * HTB)
#define PG8_STAGE(bufoff, gbase, voff) do { _Pragma("unroll") for (int _i = 0; _i < 2; ++_i) \
        __builtin_amdgcn_global_load_lds((const unsigned*)((const char*)(gbase) + (voff)[_i]), (PG8_LAS unsigned*)(lds + (bufoff) + ldsw + _i * 8192), 16, 0, 0); } while (0)
#define PG8_LDA(dst, b, h) do { _Pragma("unroll") for (int m = 0; m < 4; ++m) _Pragma("unroll") for (int k = 0; k < 2; ++k) dst[m][k] = *(const PG8_LAS bf16x8*)(lds + PG8_SA(b, h) + aoff + m * 2048 + k * 1024); } while (0)
#define PG8_LDB(dst, b, h) do { _Pragma("unroll") for (int n = 0; n < 2; ++n) _Pragma("unroll") for (int k = 0; k < 2; ++k) dst[n][k] = *(const PG8_LAS bf16x8*)(lds + PG8_SB(b, h) + boff + n * 2048 + k * 1024); } while (0)
#define PG8_MMA(ai, bj, At, Bt) do { __builtin_amdgcn_s_setprio(1); _Pragma("unroll") for (int m = 0; m < 4; ++m) _Pragma("unroll") for (int n = 0; n < 2; ++n) _Pragma("unroll") for (int k = 0; k < 2; ++k) \
        acc[ai][bj][m][n] = __builtin_amdgcn_mfma_f32_16x16x32_bf16(Bt[n][k], At[m][k], acc[ai][bj][m][n], 0, 0, 0); __builtin_amdgcn_s_setprio(0); } while (0)
#define PG8_WAIT_V(n) asm volatile("s_waitcnt vmcnt(" #n ")" ::: "memory")
#define PG8_WAIT_L(n) asm volatile("s_waitcnt lgkmcnt(" #n ")" ::: "memory")
#define PG8_BAR __builtin_amdgcn_s_barrier()
#define PG8_SCHED __builtin_amdgcn_sched_barrier(0)
    Unit cur, nxt; int ui = 0;
    if (!S.next(0, cur)) return;
    f32x4 acc[2][2][4][2];
#pragma unroll
    for (int a = 0; a < 2; ++a)
#pragma unroll
        for (int b = 0; b < 2; ++b)
#pragma unroll
            for (int m = 0; m < 4; ++m)
#pragma unroll
                for (int n = 0; n < 2; ++n) acc[a][b][m][n] = (f32x4){0.f, 0.f, 0.f, 0.f};
    bf16x8 At[4][2], B0[2][2], B1[2][2];
    const char* cA = (const char*)g.A + (size_t)cur.pm * tstep; const char* cB = (const char*)g.Bt + (size_t)cur.pn * tstep;
    S.a_ready(cur);
    if constexpr (SP2) {
        PG8_STAGE(PG8_SB(0, 0), cB, voffB); PG8_STAGE(PG8_SB(0, 1), cB + hstep, voffB); PG8_STAGE(PG8_SA(0, 0), cA, voffA); PG8_STAGE(PG8_SA(0, 1), cA + hstep, voffA);
        if (wr == 1) PG8_BAR;
        PG8_WAIT_V(2); PG8_BAR;
        PG8_STAGE(PG8_SB(1, 0), cB + kstep, voffB); PG8_STAGE(PG8_SA(1, 0), cA + kstep, voffA); PG8_STAGE(PG8_SB(1, 1), cB + hstep + kstep, voffB);
        PG8_WAIT_V(6); PG8_BAR;
    } else {
        PG8_STAGE(PG8_SB(0, 0), cB, voffB); PG8_STAGE(PG8_SA(0, 0), cA, voffA); PG8_STAGE(PG8_SB(0, 1), cB + hstep, voffB); PG8_STAGE(PG8_SA(0, 1), cA + hstep, voffA);
        if (wr == 1) PG8_BAR;
        PG8_WAIT_V(4); PG8_BAR;
        PG8_STAGE(PG8_SB(1, 0), cB + kstep, voffB); PG8_STAGE(PG8_SA(1, 0), cA + kstep, voffA); PG8_STAGE(PG8_SB(1, 1), cB + hstep + kstep, voffB);
        PG8_WAIT_V(6); PG8_BAR;
    }
    for (;;) {
        const bool has_next = S.next(ui + 1, nxt);
        const char* nA = has_next ? (const char*)g.A + (size_t)nxt.pm * tstep : cA; const char* nB = has_next ? (const char*)g.Bt + (size_t)nxt.pn * tstep : cB;
        for (int t = 0; t < nt; t += 2) {
            const bool last = (t == nt - 2);
            const char* a1 = cA + (size_t)(t + 1) * kstep;
            const char* a2 = last ? nA : cA + (size_t)(t + 2) * kstep; const char* b2 = last ? nB : cB + (size_t)(t + 2) * kstep;
            const char* a3 = a2 + kstep; const char* b3 = b2 + kstep;
            if (last && has_next) S.a_ready(nxt);
            if constexpr (SP2) {
            PG8_LDB(B0, 0, 0); PG8_LDB(B1, 0, 1); PG8_SCHED; PG8_LDA(At, 0, 0); PG8_STAGE(PG8_SA(1, 1), a1 + hstep, voffA);
            PG8_WAIT_V(8); PG8_WAIT_L(0); PG8_BAR; PG8_MMA(0, 0, At, B0); PG8_MMA(0, 1, At, B1); PG8_BAR; PG8_SCHED;
            PG8_LDA(At, 0, 1); PG8_STAGE(PG8_SB(0, 0), b2, voffB); PG8_STAGE(PG8_SB(0, 1), b2 + hstep, voffB); PG8_STAGE(PG8_SA(0, 0), a2, voffA);
            PG8_WAIT_V(8); PG8_WAIT_L(0); PG8_BAR; PG8_MMA(1, 0, At, B0); PG8_MMA(1, 1, At, B1); PG8_BAR; PG8_SCHED;
            PG8_LDB(B0, 1, 0); PG8_LDB(B1, 1, 1); PG8_SCHED; PG8_LDA(At, 1, 0); PG8_STAGE(PG8_SA(0, 1), a2 + hstep, voffA);
            PG8_WAIT_V(8); PG8_WAIT_L(0); PG8_BAR; PG8_MMA(0, 0, At, B0); PG8_MMA(0, 1, At, B1); PG8_BAR; PG8_SCHED;
            PG8_LDA(At, 1, 1); PG8_STAGE(PG8_SB(1, 0), b3, voffB); PG8_STAGE(PG8_SB(1, 1), b3 + hstep, voffB); PG8_STAGE(PG8_SA(1, 0), a3, voffA);
            PG8_WAIT_V(8); PG8_WAIT_L(0); PG8_BAR; PG8_MMA(1, 0, At, B0); PG8_MMA(1, 1, At, B1); PG8_BAR; PG8_SCHED;
            } else {
            PG8_LDB(B0, 0, 0); PG8_SCHED; PG8_LDA(At, 0, 0); PG8_STAGE(PG8_SA(1, 1), a1 + hstep, voffA);
            PG8_WAIT_L(8); PG8_BAR; PG8_WAIT_L(0); PG8_MMA(0, 0, At, B0); PG8_BAR; PG8_SCHED;
            PG8_LDB(B1, 0, 1); PG8_STAGE(PG8_SB(0, 0), b2, voffB);
            PG8_BAR; PG8_WAIT_L(0); PG8_MMA(0, 1, At, B1); PG8_BAR;
            PG8_LDA(At, 0, 1); PG8_STAGE(PG8_SA(0, 0), a2, voffA);
            PG8_BAR; PG8_WAIT_L(0); PG8_MMA(1, 0, At, B0); PG8_BAR; PG8_SCHED;
            PG8_STAGE(PG8_SB(0, 1), b2 + hstep, voffB);
            PG8_WAIT_V(6); PG8_BAR; PG8_MMA(1, 1, At, B1); PG8_BAR;
            PG8_LDB(B0, 1, 0); PG8_SCHED; PG8_LDA(At, 1, 0); PG8_STAGE(PG8_SA(0, 1), a2 + hstep, voffA);
            PG8_WAIT_L(8); PG8_BAR; PG8_WAIT_L(0); PG8_MMA(0, 0, At, B0); PG8_BAR; PG8_SCHED;
            PG8_LDB(B1, 1, 1); PG8_STAGE(PG8_SB(1, 0), b3, voffB);
            PG8_BAR; PG8_WAIT_L(0); PG8_MMA(0, 1, At, B1); PG8_BAR;
            PG8_LDA(At, 1, 1); PG8_STAGE(PG8_SA(1, 0), a3, voffA);
            PG8_BAR; PG8_WAIT_L(0); PG8_MMA(1, 0, At, B0); PG8_BAR; PG8_SCHED;
            PG8_STAGE(PG8_SB(1, 1), b3 + hstep, voffB);
            PG8_WAIT_V(6); PG8_BAR; PG8_MMA(1, 1, At, B1); PG8_BAR;
            }
        }
        if constexpr (ALIGN_EPI) { if (wr == 0) PG8_BAR; }
        if constexpr (!Epi::AFTER_DRAIN) { E(acc, cur, wr, wc, fr, fq); S.done(cur); }
        if (!has_next) break;
#pragma unroll
        for (int a = 0; a < 2; ++a)
#pragma unroll
            for (int b = 0; b < 2; ++b)
#pragma unroll
                for (int m = 0; m < 4; ++m)
#pragma unroll
                    for (int n = 0; n < 2; ++n) acc[a][b][m][n] = (f32x4){0.f, 0.f, 0.f, 0.f};
        cur = nxt; cA = nA; cB = nB; ++ui;
        if constexpr (ALIGN_EPI) { if (wr == 1) PG8_BAR; }
    }
    PG8_WAIT_V(0);
    if constexpr (!ALIGN_EPI) { if (wr == 0) PG8_BAR; }
    PG8_BAR;
    if constexpr (Epi::AFTER_DRAIN) { E.fused(acc, cur, wr, wc, fr, fq, lds, wid, lane); S.done(cur); }
#undef PG8_SA
#undef PG8_SB
#undef PG8_STAGE
#undef PG8_LDA
#undef PG8_LDB
#undef PG8_MMA
#undef PG8_WAIT_V
#undef PG8_WAIT_L
#undef PG8_BAR
#undef PG8_SCHED
}
}

typedef unsigned short bf16;
typedef float f32x4 __attribute__((ext_vector_type(4)));
typedef unsigned u32x4 __attribute__((ext_vector_type(4)));
typedef unsigned u32x2 __attribute__((ext_vector_type(2)));
typedef short bf16x8 __attribute__((ext_vector_type(8)));
#define LAS __attribute__((address_space(3)))

constexpr int NB = 8, SEQ = 2048, DM = 1024, NH = 8, FF = 2816, DIN = 9232;
constexpr int M = NB * SEQ;
constexpr float EPS = 1e-6f;
constexpr float LAMBDA_INIT = 0.2f;
constexpr size_t MiB = 1u << 20;
constexpr size_t WS_G = 1 * MiB, WS_BETA = 1 * MiB + 512 * 1024, WS_HALO = 2 * MiB, WS_RSS = 7 * MiB;
constexpr size_t WS_WIN = 8 * MiB, WS_WOUT = 26 * MiB, WS_WGU = 28 * MiB, WS_WD = 39 * MiB;
constexpr size_t WS_GZ = 45 * MiB, WS_GA = 77 * MiB, WS_TQ = 109 * MiB, WS_TK = 141 * MiB, WS_TV = 173 * MiB, WS_AQK = 205 * MiB;
constexpr size_t WS_DQ = 109 * MiB, WS_DK = 141 * MiB, WS_DVT = 173 * MiB, WS_GB = 205 * MiB;
constexpr size_t WS_H1B = 77 * MiB, WS_HFF = 109 * MiB;
constexpr size_t WS_U = 221 * MiB, WS_GL = 512 * 1024;
constexpr size_t WS_NEED = 253 * MiB;
constexpr int LDS_BYTES = 147456, MISC_OFF = 131072;

__device__ __forceinline__ float bf2f(unsigned short v) { return __uint_as_float((unsigned)v << 16); }
__device__ __forceinline__ unsigned f2bf(float f) { return pg8::pk_bf16(f, 0.f) & 0xffffu; }
__device__ __forceinline__ unsigned pk2(float lo, float hi) { return pg8::pk_bf16(lo, hi); }
__device__ __forceinline__ float lo16(unsigned w) { return __uint_as_float(w << 16); }
__device__ __forceinline__ float hi16(unsigned w) { return __uint_as_float(w & 0xffff0000u); }
__device__ __forceinline__ float sigmoidf_(float x) { return __builtin_amdgcn_rcpf(1.0f + __expf(-x)); }
__device__ __forceinline__ float siluf_(float x) { return x * __builtin_amdgcn_rcpf(1.0f + __expf(-x)); }
__device__ __forceinline__ void unpack8(const u32x4& w, float* o) { o[0] = lo16(w.x); o[1] = hi16(w.x); o[2] = lo16(w.y); o[3] = hi16(w.y); o[4] = lo16(w.z); o[5] = hi16(w.z); o[6] = lo16(w.w); o[7] = hi16(w.w); }

struct Args { const float* in[19]; float* out; unsigned char* ws; int ph_lo, ph_hi; };
#ifndef G1_REP_A
#define G1_REP_A 1
#endif
#ifndef G1_REP_C
#define G1_REP_C 1
#endif
#ifndef G1_REP_D1
#define G1_REP_D1 1
#endif
#ifndef G1_REP_D2
#define G1_REP_D2 1
#endif
#ifndef G1_REP_E
#define G1_REP_E 1
#endif
#ifndef REP_P1
#define REP_P1 1
#endif
#ifndef REP_P6
#define REP_P6 1
#endif
#ifndef REP_P8
#define REP_P8 1
#endif
#ifndef REP_SYNC
#define REP_SYNC 0
#endif
#ifndef REP_P0
#define REP_P0 1
#endif
#ifndef REP_P1G1
#define REP_P1G1 1
#endif
#ifndef REP_G2
#define REP_G2 1
#endif
#ifndef REP_ATT
#define REP_ATT 1
#endif
#ifndef REP_P4
#define REP_P4 1
#endif
#ifndef REP_P7
#define REP_P7 1
#endif

__device__ __forceinline__ size_t oraw_idx(int row, int h, int e) { return (size_t)row * 1024 + h * 128 + e; }

__device__ __forceinline__ void transpose_item(const float* W, int ldw, int src_col0, bf16* WT, int K, int dst_row0, int k0, const float* kscale, float* scr, int lane) {
    float tv[32];
#pragma unroll
    for (int i = 0; i < 32; ++i) { const int kk = 2 * i + (lane >> 5); tv[i] = __builtin_nontemporal_load(W + (size_t)(k0 + kk) * ldw + src_col0 + (lane & 31)); }
#pragma unroll
    for (int i = 0; i < 32; ++i) { const int kk = 2 * i + (lane >> 5); float v = tv[i]; if (kscale) v *= kscale[k0 + kk]; scr[kk * 33 + (lane & 31)] = v; }
    asm volatile("s_waitcnt lgkmcnt(0)" ::: "memory");
    const int c = lane & 7;
#pragma unroll
    for (int j = 0; j < 4; ++j) { const int n = (lane >> 3) + 8 * j; const float* s = scr + (8 * c) * 33 + n;
        u32x4 o; o.x = pk2(s[0 * 33], s[1 * 33]); o.y = pk2(s[2 * 33], s[3 * 33]); o.z = pk2(s[4 * 33], s[5 * 33]); o.w = pk2(s[6 * 33], s[7 * 33]);
        *(u32x4*)(WT + (size_t)(dst_row0 + n) * K + k0 + 8 * c) = o; }
    asm volatile("s_waitcnt lgkmcnt(0)" ::: "memory");
}
__device__ __forceinline__ int win_src_col(int r) {
    if (r < 4096) return r;
    if (r < 5120) return r - 4096 + 7184;
    if (r < 7168) {
        const int base = r < 6144 ? 4112 : 5136, rr = (r - 5120) & 1023;
        return base + (4 * (rr >> 8) + ((rr >> 5) & 3)) * 64 + 32 * ((rr >> 7) & 1) + (rr & 31);
    }
    if (r < 8192) return r - 7168 + 8208;
    return r - 8192 + 6160;
}
__device__ __forceinline__ void p0_prologue(const Args& a, unsigned char* lds, int tid, int lane, int wave, int vcu, int G) {
    unsigned char* ws = a.ws;
    const int gw = vcu * 8 + wave, NGW = G * 8;
    float* scr = (float*)(lds + 65536 + wave * 8704);
    constexpr int I_IN = 16 * 288, I_OUT = 16 * 32, I_GU = 16 * 176, I_D = 44 * 32, NITEMS = I_IN + I_OUT + I_GU + I_D;
    for (int it = gw; it < NITEMS; it += NGW) {
        int r = it;
        if (r < I_IN) { const int kb = r / 288, nb = r % 288; transpose_item(a.in[2], DIN, win_src_col(nb * 32), (bf16*)(ws + WS_WIN), 1024, nb * 32, kb * 64, nullptr, scr, lane); continue; } r -= I_IN;
        if (r < I_OUT) { const int kb = r / 32, nb = r % 32; transpose_item(a.in[14], 1024, nb * 32, (bf16*)(ws + WS_WOUT), 1024, nb * 32, kb * 64, nullptr, scr, lane); continue; } r -= I_OUT;
        if (r < I_GU) { const int kb = r / 176, nb = r % 176; const int dr = nb * 32, tile = dr >> 8, within = dr & 255;
            const float* W = within < 128 ? a.in[16] : a.in[17]; const int sc = tile * 128 + (within & 127);
            transpose_item(W, FF, sc, (bf16*)(ws + WS_WGU), 1024, dr, kb * 64, a.in[15], scr, lane); continue; } r -= I_GU;
        { const int kb = r / 32, nb = r % 32; transpose_item(a.in[18], 1024, nb * 32, (bf16*)(ws + WS_WD), FF, nb * 32, kb * 64, nullptr, scr, lane); }
    }
    f32x4* wab = (f32x4*)lds;
    for (int i = tid; i < 4096; i += 512) { const int k = i >> 2, q = i & 3, j = k >> 8, l = (k & 255) >> 2, e = k & 3;
        wab[((j * 4 + e) * 4 + q) * 64 + l] = *(const f32x4*)(a.in[2] + (size_t)k * DIN + 4096 + q * 4); }
    __syncthreads();
    const float* x = a.in[0];
    bf16* XN = (bf16*)a.out;
    float* gbuf = (float*)(ws + WS_G); float* bbuf = (float*)(ws + WS_BETA);
    f32x4 n1[4];
#pragma unroll
    for (int j = 0; j < 4; ++j) n1[j] = ((const f32x4*)a.in[1])[64 * j + lane];
    f32x4 xn[4];
    if (gw < M) {
#pragma unroll
        for (int j = 0; j < 4; ++j) xn[j] = __builtin_nontemporal_load((const f32x4*)(x + (size_t)gw * DM) + lane + 64 * j);
    }
    for (int m = gw; m < M; m += NGW) {
        f32x4 t[4]; float ss = 0.f;
#pragma unroll
        for (int j = 0; j < 4; ++j) { const f32x4 v = xn[j]; ss += (v.x * v.x + v.y * v.y) + (v.z * v.z + v.w * v.w); t[j] = v * n1[j]; }
        if (m + NGW < M) {
#pragma unroll
            for (int j = 0; j < 4; ++j) xn[j] = __builtin_nontemporal_load((const f32x4*)(x + (size_t)(m + NGW) * DM) + lane + 64 * j);
        }
        typedef float f32x2q __attribute__((ext_vector_type(2)));
        f32x2q acc2[8];
#pragma unroll
        for (int c = 0; c < 8; ++c) acc2[c] = (f32x2q){0.f, 0.f};
        f32x4 wA[4], wB[4];
#define P0_LDW(Wd, je) do { _Pragma("unroll") for (int q = 0; q < 4; ++q) Wd[q] = wab[(((je)) * 4 + q) * 64 + lane]; } while (0)
#define P0_FMA(Wd, je) do { const float tv_ = t[(je) >> 2][(je) & 3]; const f32x2q tv2_ = {tv_, tv_}; _Pragma("unroll") for (int q = 0; q < 4; ++q) { \
            acc2[q * 2] += tv2_ * (f32x2q){Wd[q].x, Wd[q].y}; acc2[q * 2 + 1] += tv2_ * (f32x2q){Wd[q].z, Wd[q].w}; } } while (0)
        P0_LDW(wA, 0); __builtin_amdgcn_sched_barrier(0);
#pragma unroll
        for (int je = 0; je < 16; je += 2) {
            P0_LDW(wB, je + 1); __builtin_amdgcn_sched_barrier(0); P0_FMA(wA, je); __builtin_amdgcn_sched_barrier(0);
            if (je + 2 < 16) P0_LDW(wA, je + 2);
            __builtin_amdgcn_sched_barrier(0); P0_FMA(wB, je + 1); __builtin_amdgcn_sched_barrier(0);
        }
#undef P0_LDW
#undef P0_FMA
        float acc[16];
#pragma unroll
        for (int c = 0; c < 8; ++c) { acc[2 * c] = acc2[c].x; acc[2 * c + 1] = acc2[c].y; }
#pragma unroll
        for (int o = 1; o < 64; o <<= 1) ss += __shfl_xor(ss, o);
        {
            const bool b5 = lane & 32, b4 = lane & 16, b3 = lane & 8, b2 = lane & 4;
#pragma unroll
            for (int i = 0; i < 8; ++i) { const float send = b5 ? acc[i] : acc[i + 8], keep = b5 ? acc[i + 8] : acc[i]; acc[i] = keep + __shfl_xor(send, 32); }
#pragma unroll
            for (int i = 0; i < 4; ++i) { const float send = b4 ? acc[i] : acc[i + 4], keep = b4 ? acc[i + 4] : acc[i]; acc[i] = keep + __shfl_xor(send, 16); }
#pragma unroll
            for (int i = 0; i < 2; ++i) { const float send = b3 ? acc[i] : acc[i + 2], keep = b3 ? acc[i + 2] : acc[i]; acc[i] = keep + __shfl_xor(send, 8); }
            { const float send = b2 ? acc[0] : acc[1], keep = b2 ? acc[1] : acc[0]; acc[0] = keep + __shfl_xor(send, 4); }
            acc[0] += __shfl_xor(acc[0], 2); acc[0] += __shfl_xor(acc[0], 1);
        }
        const float rstd = __builtin_amdgcn_rsqf(ss * (1.0f / DM) + EPS);
        u32x2* o8 = (u32x2*)(XN + (size_t)m * DM) + lane;
#pragma unroll
        for (int j = 0; j < 4; ++j) { u32x2 w; w.x = pk2(t[j].x * rstd, t[j].y * rstd); w.y = pk2(t[j].z * rstd, t[j].w * rstd); o8[64 * j] = w; }
        if ((lane & 3) == 0) {
            const int c = ((lane & 32) ? 8 : 0) + ((lane & 16) ? 4 : 0) + ((lane & 8) ? 2 : 0) + ((lane & 4) ? 1 : 0);
            const float v = acc[0] * rstd;
            if (c < 8) { const float z = v + a.in[5][c]; const float sp = (z > 20.f) ? z : log1pf(expf(z)); gbuf[(size_t)m * 8 + c] = -expf(a.in[4][c]) * sp; }
            else bbuf[(size_t)m * 8 + (c - 8)] = 1.0f / (1.0f + expf(-v));
        }
    }
}

__device__ __forceinline__ void g1_load_raw(const Args& a, int item, int tid, u32x4 (&raw)[11]) {
    const int chunk = item >> 3, h = item & 7, n = chunk & 31, t = tid >> 7, c8 = tid & 15, toct = (tid >> 4) & 7;
    if (t < 3) {
        const bf16* tile = (const bf16*)(a.ws + (t == 0 ? WS_TQ : t == 1 ? WS_TK : WS_TV)) + (size_t)item * 8192;
        const bf16* hal = (const bf16*)(a.ws + WS_HALO) + ((size_t)((chunk - 1) * 8 + h) * 3 + t) * 384;
#pragma unroll
        for (int r = 0; r < 11; ++r) {
            const int tok = toct * 8 - 3 + r;
            u32x4 w = {0u, 0u, 0u, 0u};
            if (tok >= 0) w = *(const u32x4*)(tile + tok * 128 + c8 * 8);
            else if (n > 0) w = *(const u32x4*)(hal + (tok + 3) * 128 + c8 * 8);
            raw[r] = w;
        }
    }
}
__device__ __forceinline__ void g1_item(const Args& a, unsigned char* lds, int item, int next_item, u32x4 (&raw)[11], int tid_in, int lane_in, int wave) {
    int tid = tid_in; asm volatile("" : "+v"(tid));
    const int lane = tid & 63; (void)lane_in;
    unsigned char* ws = a.ws;
    const int chunk = item >> 3, h = item & 7, n = chunk & 31;
    unsigned char* QS = lds; unsigned char* KS = lds + 16384;
    constexpr int RS = 264;
    bf16* RHS = (bf16*)(lds + 32768);
    constexpr int WS_ = 136, AS_ = 72;
    bf16* QDR = (bf16*)(lds + 66560);
    constexpr int KTS = 72;
    bf16* KDT = (bf16*)(lds + 83968);
    float* LM = (float*)(lds + 102400); bf16* AQR = (bf16*)(lds + 118784);
    float* gcs = (float*)(lds + 128000); float* egc = gcs + 64; float* bet = gcs + 128; float* ekd = gcs + 192;
    bf16* LB = (bf16*)(lds + 129024);
    bf16* TB = (bf16*)(lds + 138240);
    bf16* WROW = (bf16*)lds;
    const float* gbuf = (const float*)(ws + WS_G); const float* bbuf = (const float*)(ws + WS_BETA);
    unsigned char* blobW = ws + WS_TQ + (size_t)item * 16384; unsigned char* blobQD = ws + WS_TK + (size_t)item * 16384; unsigned char* blobKD = ws + WS_TV + (size_t)item * 16384;
    unsigned char* blobA = ws + WS_AQK + (size_t)item * 8192; unsigned char* blobU = ws + WS_U + (size_t)item * 16384;
    if (wave == 7) {
        const int row = chunk * 64 + lane;
        float sc = gbuf[(size_t)row * 8 + h];
#pragma unroll
        for (int o = 1; o < 64; o <<= 1) { const float t = __shfl_up(sc, o); if (lane >= o) sc += t; }
        const float glast = __shfl(sc, 63);
        gcs[lane] = sc; egc[lane] = __expf(sc); bet[lane] = bbuf[(size_t)row * 8 + h]; ekd[lane] = __expf(glast - sc);
        if (lane == 0) ((float*)(ws + WS_GL))[item] = __expf(glast);
    }
    {
    const int t = tid >> 7, c8 = tid & 15, toct = (tid >> 4) & 7;
    float outv[8][8];
    if (t < 3) {
        float xin[11][8];
#pragma unroll
        for (int r = 0; r < 11; ++r) unpack8(raw[r], xin[r]);
        float cw[4][8];
#pragma unroll
        for (int j = 0; j < 4; ++j) { const float* p = a.in[3] + (size_t)j * 3072 + t * 1024 + h * 128 + c8 * 8; const f32x4 w0 = *(const f32x4*)p, w1 = *(const f32x4*)(p + 4);
            cw[j][0] = w0.x; cw[j][1] = w0.y; cw[j][2] = w0.z; cw[j][3] = w0.w; cw[j][4] = w1.x; cw[j][5] = w1.y; cw[j][6] = w1.z; cw[j][7] = w1.w; }
#pragma unroll
        for (int i = 0; i < 8; ++i) {
            float ss = 0.f;
#pragma unroll
            for (int e = 0; e < 8; ++e) { float sv = 0.f;
#pragma unroll
                for (int j = 0; j < 4; ++j) sv += cw[j][e] * xin[i + j][e];
                sv = siluf_(sv); outv[i][e] = sv; ss += sv * sv; }
            if (t < 2) {
                ss += __shfl_xor(ss, 1); ss += __shfl_xor(ss, 2); ss += __shfl_xor(ss, 4); ss += __shfl_xor(ss, 8);
                const float sc = __builtin_amdgcn_rsqf(ss + EPS) * (t == 0 ? 0.08838834764831845f : 1.0f);
#pragma unroll
                for (int e = 0; e < 8; ++e) outv[i][e] *= sc;
            }
        }
    }
    __syncthreads();
    if (t < 3) {
        float fbe[8], feg[8], fkd[8];
        { const f32x4 b0 = *(const f32x4*)(bet + toct * 8), b1 = *(const f32x4*)(bet + toct * 8 + 4), e0 = *(const f32x4*)(egc + toct * 8), e1 = *(const f32x4*)(egc + toct * 8 + 4),
                      k0 = *(const f32x4*)(ekd + toct * 8), k1 = *(const f32x4*)(ekd + toct * 8 + 4);
#pragma unroll
          for (int q = 0; q < 4; ++q) { fbe[q] = b0[q]; fbe[4 + q] = b1[q]; feg[q] = e0[q]; feg[4 + q] = e1[q]; fkd[q] = k0[q]; fkd[4 + q] = k1[q]; } }
#pragma unroll
        for (int i8 = 0; i8 < 8; ++i8) {
            const int tok = toct * 8 + i8;
            if (t < 2) {
                u32x4 w; w.x = pk2(outv[i8][0], outv[i8][1]); w.y = pk2(outv[i8][2], outv[i8][3]); w.z = pk2(outv[i8][4], outv[i8][5]); w.w = pk2(outv[i8][6], outv[i8][7]);
                *(u32x4*)((t == 0 ? QS : KS) + ((((tok >> 4) * 4 + (c8 >> 2)) * 64) + (c8 & 3) * 16 + ((tok & 15) ^ (2 * (c8 & 3)) ^ ((c8 >> 2) & 1))) * 16) = w;
            }
            if (t >= 1) {
                const float f = (t == 1) ? fbe[i8] * feg[i8] : fbe[i8];
                u32x4 w; w.x = pk2(outv[i8][0] * f, outv[i8][1] * f); w.y = pk2(outv[i8][2] * f, outv[i8][3] * f); w.z = pk2(outv[i8][4] * f, outv[i8][5] * f); w.w = pk2(outv[i8][6] * f, outv[i8][7] * f);
                *(u32x4*)(RHS + tok * RS + (t == 1 ? 128 : 0) + c8 * 8) = w;
            }
            if (t == 0) {
                const float f = feg[i8];
                u32x4 w; w.x = pk2(outv[i8][0] * f, outv[i8][1] * f); w.y = pk2(outv[i8][2] * f, outv[i8][3] * f); w.z = pk2(outv[i8][4] * f, outv[i8][5] * f); w.w = pk2(outv[i8][6] * f, outv[i8][7] * f);
                *(u32x4*)(QDR + tok * WS_ + c8 * 8) = w;
            }
        }
        if (t == 1) {
            float f[8];
#pragma unroll
            for (int i8 = 0; i8 < 8; ++i8) f[i8] = fkd[i8];
#pragma unroll
            for (int e = 0; e < 8; ++e) {
                u32x4 w; w.x = pk2(outv[0][e] * f[0], outv[1][e] * f[1]); w.y = pk2(outv[2][e] * f[2], outv[3][e] * f[3]); w.z = pk2(outv[4][e] * f[4], outv[5][e] * f[5]); w.w = pk2(outv[6][e] * f[6], outv[7][e] * f[7]);
                *(u32x4*)(KDT + (c8 * 8 + e) * KTS + (toct ^ (c8 & 7)) * 8) = w;
            }
        }
    }
    __syncthreads();
    if (next_item >= 0) g1_load_raw(a, next_item, tid, raw);
    }
    {
    {
        const int prod = wave >> 2, it = wave & 3, i16 = lane & 15, g = lane >> 4;
        const unsigned char* AS = prod == 0 ? KS : QS;
        bf16x8 af[4], bfr[4][4];
#pragma unroll
        for (int ks = 0; ks < 4; ++ks) af[ks] = *(const bf16x8*)(AS + (((it * 4 + ks) * 64) + g * 16 + (i16 ^ (2 * g) ^ (ks & 1))) * 16);
#pragma unroll
        for (int jt = 0; jt < 4; ++jt)
            if (jt <= it) {
#pragma unroll
                for (int ks = 0; ks < 4; ++ks) bfr[jt][ks] = *(const bf16x8*)(KS + (((jt * 4 + ks) * 64) + g * 16 + (i16 ^ (2 * g) ^ (ks & 1))) * 16);
            }
        const f32x4 gci = *(const f32x4*)(gcs + 16 * it + 4 * g), bti = *(const f32x4*)(bet + 16 * it + 4 * g);
        float gcj[4];
#pragma unroll
        for (int jt = 0; jt < 4; ++jt) gcj[jt] = gcs[16 * jt + i16];
        __builtin_amdgcn_sched_barrier(0);
        f32x4 accs[4];
#pragma unroll
        for (int jt = 0; jt < 4; ++jt) {
            f32x4 a0 = {0.f, 0.f, 0.f, 0.f}, a1 = {0.f, 0.f, 0.f, 0.f};
            if (jt <= it) {
                a0 = __builtin_amdgcn_mfma_f32_16x16x32_bf16(af[0], bfr[jt][0], a0, 0, 0, 0); a1 = __builtin_amdgcn_mfma_f32_16x16x32_bf16(af[1], bfr[jt][1], a1, 0, 0, 0);
                a0 = __builtin_amdgcn_mfma_f32_16x16x32_bf16(af[2], bfr[jt][2], a0, 0, 0, 0); a1 = __builtin_amdgcn_mfma_f32_16x16x32_bf16(af[3], bfr[jt][3], a1, 0, 0, 0);
            }
            accs[jt] = a0 + a1;
        }
#pragma unroll
        for (int jt = 0; jt < 4; ++jt) {
            const f32x4 acc = accs[jt];
            const int j = 16 * jt + i16; const float gj = gcj[jt];
#pragma unroll
            for (int r = 0; r < 4; ++r) {
                const int i = 16 * it + 4 * g + r;
                const float dec = __expf(fminf(gci[r] - gj, 0.f));
                if (prod == 0) { if (jt <= it) { const float lv0 = bti[r] * acc[r] * dec; const float lv = (i > j) ? lv0 : 0.f; if (jt == it) LM[i * 64 + j] = lv; LB[i * AS_ + j] = (bf16)f2bf(-lv); } }
                else { const float av0 = acc[r] * dec; AQR[i * AS_ + j] = (bf16)f2bf((jt <= it && i >= j) ? av0 : 0.f); }
            }
        }
    }
    if (wave < 4) {
        int vz; asm volatile("v_mov_b32 %0, 0" : "=v"(vz));
        const int c = lane & 15;
        const f32x4* Lb4 = (const f32x4*)(LM + (16 * wave) * 64 + 16 * wave) + vz;
        float T[16];
        f32x4 rowA[4], rowB[4];
#define D1_LD(R, i) do { _Pragma("unroll") for (int q = 0; q < 4; ++q) if (4 * q < (i)) R[q] = Lb4[(i) * 16 + q]; } while (0)
#define D1_ROW(R, i) do { float sacc = ((i) == c) ? 1.0f : 0.0f; _Pragma("unroll") for (int j = 0; j < (i); ++j) sacc -= R[j >> 2][j & 3] * T[j]; T[i] = sacc; } while (0)
        T[0] = (c == 0) ? 1.0f : 0.0f;
        D1_LD(rowA, 1); __builtin_amdgcn_sched_barrier(0);
#pragma unroll
        for (int i = 1; i < 16; i += 2) {
            D1_LD(rowB, i + 1); __builtin_amdgcn_sched_barrier(0); D1_ROW(rowA, i); __builtin_amdgcn_sched_barrier(0);
            if (i + 1 < 16) { if (i + 2 < 16) D1_LD(rowA, i + 2); __builtin_amdgcn_sched_barrier(0); D1_ROW(rowB, i + 1); __builtin_amdgcn_sched_barrier(0); }
        }
#undef D1_LD
#undef D1_ROW
        if (lane < 16) {
#pragma unroll
            for (int i = 0; i < 16; ++i) TB[(wave * 16 + i) * 16 + c] = (bf16)f2bf(T[i]);
        }
    }
    __syncthreads();
    }
    {
    {
        typedef short bf16x4 __attribute__((ext_vector_type(4)));
        const int i16 = lane & 15, g = lane >> 4;
        bf16x4 lf[4][3], tf[4]; float rh[2][4][4];
#pragma unroll
        for (int bb = 0; bb < 4; ++bb) {
            tf[bb] = *(const bf16x4*)(TB + (bb * 16 + i16) * 16 + 4 * g);
#pragma unroll
            for (int b2 = 0; b2 < 3; ++b2) if (b2 < bb) lf[bb][b2] = *(const bf16x4*)(LB + (16 * bb + i16) * AS_ + 16 * b2 + 4 * g);
#pragma unroll
            for (int ct = 0; ct < 2; ++ct)
#pragma unroll
                for (int r = 0; r < 4; ++r) rh[ct][bb][r] = bf2f(RHS[(16 * bb + 4 * g + r) * RS + (ct == 0 ? 0 : 128) + 16 * wave + i16]);
        }
        __builtin_amdgcn_sched_barrier(0);
        bf16x4 xb[2][4];
#pragma unroll
        for (int bb = 0; bb < 4; ++bb) {
            f32x4 acc[2];
#pragma unroll
            for (int ct = 0; ct < 2; ++ct) acc[ct] = (f32x4){rh[ct][bb][0], rh[ct][bb][1], rh[ct][bb][2], rh[ct][bb][3]};
#pragma unroll
            for (int b2 = 0; b2 < 3; ++b2) if (b2 < bb) {
#pragma unroll
                for (int ct = 0; ct < 2; ++ct) acc[ct] = __builtin_amdgcn_mfma_f32_16x16x16bf16_1k(lf[bb][b2], xb[ct][b2], acc[ct], 0, 0, 0);
            }
            f32x4 X[2];
#pragma unroll
            for (int ct = 0; ct < 2; ++ct) { u32x2 pa; pa.x = pk2(acc[ct][0], acc[ct][1]); pa.y = pk2(acc[ct][2], acc[ct][3]);
                X[ct] = __builtin_amdgcn_mfma_f32_16x16x16bf16_1k(tf[bb], __builtin_bit_cast(bf16x4, pa), (f32x4){0.f, 0.f, 0.f, 0.f}, 0, 0, 0); }
#pragma unroll
            for (int ct = 0; ct < 2; ++ct) { u32x2 px; px.x = pk2(X[ct][0], X[ct][1]); px.y = pk2(X[ct][2], X[ct][3]); xb[ct][bb] = __builtin_bit_cast(bf16x4, px);
                if (ct == 0) *(u32x2*)(blobU + (size_t)(((wave * 4 + bb) * 64) + lane) * 8) = px;
                else {
#pragma unroll
                    for (int r = 0; r < 4; ++r) WROW[(16 * bb + 4 * g + r) * WS_ + 16 * wave + i16] = (bf16)(((r & 2) ? px.y : px.x) >> ((r & 1) * 16));
                } }
        }
    }
    __syncthreads();
    }
    {
#pragma unroll
    for (int j = 0; j < 2; ++j) { const int f = tid + 512 * j, frag = f >> 6, ln = f & 63, i = ln & 15, g = ln >> 4, it = frag >> 2, ks = frag & 3;
        const bf16* src = WROW + (16 * it + i) * WS_ + 32 * ks + 4 * g;
        const u32x2 p0 = *(const u32x2*)src, p1 = *(const u32x2*)(src + 16);
        *(u32x4*)(blobW + f * 16) = (u32x4){p0.x, p0.y, p1.x, p1.y}; }
#pragma unroll
    for (int j = 0; j < 2; ++j) { const int f = tid + 512 * j, frag = f >> 6, ln = f & 63, i = ln & 15, g = ln >> 4, it = frag >> 2, ks = frag & 3;
        const bf16* src = QDR + (16 * it + i) * WS_ + 32 * ks + 4 * g;
        const u32x2 p0 = *(const u32x2*)src, p1 = *(const u32x2*)(src + 16);
        *(u32x4*)(blobQD + f * 16) = (u32x4){p0.x, p0.y, p1.x, p1.y}; }
#pragma unroll
    for (int j = 0; j < 2; ++j) { const int f = tid + 512 * j, frag = f >> 6, ln = f & 63, i = ln & 15, g = ln >> 4, dt = frag >> 1, ks2 = frag & 1;
        const int ksw = (2 * dt + (i >> 3)) & 7;
        const bf16* rowp = KDT + (16 * dt + i) * KTS + 4 * (g & 1);
        const u32x2 p0 = *(const u32x2*)(rowp + (((4 * ks2 + (g >> 1)) ^ ksw) * 8)), p1 = *(const u32x2*)(rowp + (((4 * ks2 + 2 + (g >> 1)) ^ ksw) * 8));
        *(u32x4*)(blobKD + f * 16) = (u32x4){p0.x, p0.y, p1.x, p1.y}; }
    {
        const int f = tid, frag = f >> 6, ln = f & 63, i = ln & 15, g = ln >> 4, it = frag >> 1, ks2 = frag & 1;
        const bf16* src = AQR + (16 * it + i) * AS_ + 32 * ks2 + 4 * g;
        const u32x2 p0 = *(const u32x2*)src, p1 = *(const u32x2*)(src + 16);
        *(u32x4*)(blobA + f * 16) = (u32x4){p0.x, p0.y, p1.x, p1.y};
    }
    }
}

__device__ __forceinline__ void g2_item(const Args& a, unsigned char* lds, int item, int tid, int lane, int wave) {
    unsigned char* ws = a.ws;
    const int bh = item >> 2, eq = item & 3, b = bh >> 3, h = bh & 7, et = eq * 2 + (wave & 1);
    bf16* ORAW = (bf16*)a.out + (size_t)M * DM;
    const float* GL = (const float*)(ws + WS_GL);
    constexpr int STG = 57344;
    f32x4 S[8];
#pragma unroll
    for (int dt = 0; dt < 8; ++dt) S[dt] = (f32x4){0.f, 0.f, 0.f, 0.f};
    u32x2 uA[4];
#define G2_SRC(IT8, j) ((j) < 2 ? ws + WS_TQ + (IT8) * 16384 + (size_t)(tid + 512 * (j)) * 16 : (j) < 4 ? ws + WS_TK + (IT8) * 16384 + (size_t)(tid + 512 * ((j) - 2)) * 16 \
        : (j) < 6 ? ws + WS_TV + (IT8) * 16384 + (size_t)(tid + 512 * ((j) - 4)) * 16 : ws + WS_AQK + (IT8) * 8192 + (size_t)tid * 16)
#define G2_DMA(N) do { const size_t it8_ = (size_t)(b * 32 + (N)) * 8 + h; LAS unsigned char* nb_ = (LAS unsigned char*)lds + ((N) & 1) * STG + wave * 1024; \
        _Pragma("unroll") for (int j = 0; j < 7; ++j) __builtin_amdgcn_global_load_lds((const unsigned*)G2_SRC(it8_, j), (LAS unsigned*)(nb_ + (j < 6 ? j * 8192 : 49152)), 16, 0, 0); } while (0)
#define G2_LOADU(UR, N) do { if (wave < 2) { int lu_ = lane; asm volatile("" : "+v"(lu_)); const size_t it8_ = (size_t)(b * 32 + (N)) * 8 + h; _Pragma("unroll") for (int tt = 0; tt < 4; ++tt) UR[tt] = *(const u32x2*)(ws + WS_U + it8_ * 16384 + (size_t)(((et * 4 + tt) * 64) + lu_) * 8); } } while (0)
    G2_DMA(0); G2_LOADU(uA, 0);
    asm volatile("s_waitcnt vmcnt(0)" ::: "memory");
    __syncthreads();
    for (int n = 0; n < 32; n += 2) {
#pragma unroll
        for (int half = 0; half < 2; ++half) {
            const int N_ = n + half;
            if (N_ + 1 < 32) G2_DMA(N_ + 1);
            u32x2 (&UC_)[4] = uA;
            const float eg = GL[(size_t)(b * 32 + N_) * 8 + h];
        if (wave < 2) {
                int lq_ = lane; asm volatile("" : "+v"(lq_));
                const int i16 = lq_ & 15, g = lq_ >> 4;
                const unsigned char* B = lds + (N_ & 1) * STG;
                bf16x8 sf[4];
    #pragma unroll
                for (int ks = 0; ks < 4; ++ks) { const u32x4 w = pg8::pk8(S[2 * ks], S[2 * ks + 1]); sf[ks] = __builtin_bit_cast(bf16x8, w); }
                const unsigned char* Bl = B + lq_ * 16;
                bf16x8 fA[8], fB[8];
                f32x4 accA[4], accC[4];
#pragma unroll
                for (int tt = 0; tt < 4; ++tt) { accA[tt] = (f32x4){0.f, 0.f, 0.f, 0.f}; accC[tt] = (f32x4){0.f, 0.f, 0.f, 0.f}; }
#define G2_SCHED __builtin_amdgcn_sched_barrier(0)
#define G2_LD1(F, ks) do { _Pragma("unroll") for (int tt = 0; tt < 4; ++tt) { F[tt] = *(const bf16x8*)(Bl + ((tt * 4 + (ks)) * 64) * 16); F[4 + tt] = *(const bf16x8*)(Bl + 16384 + ((tt * 4 + (ks)) * 64) * 16); } } while (0)
#define G2_MM1(F, ks) do { _Pragma("unroll") for (int tt = 0; tt < 4; ++tt) { accA[tt] = __builtin_amdgcn_mfma_f32_16x16x32_bf16(F[tt], sf[ks], accA[tt], 0, 0, 0); accC[tt] = __builtin_amdgcn_mfma_f32_16x16x32_bf16(F[4 + tt], sf[ks], accC[tt], 0, 0, 0); } } while (0)
#define G2_LDK(F, k2) do { _Pragma("unroll") for (int dt = 0; dt < 8; ++dt) F[dt] = *(const bf16x8*)(Bl + 32768 + ((dt * 2 + (k2)) * 64) * 16); } while (0)
#define G2_MMK(F, k2) do { _Pragma("unroll") for (int dt = 0; dt < 8; ++dt) S[dt] = __builtin_amdgcn_mfma_f32_16x16x32_bf16(F[dt], vf[k2], S[dt], 0, 0, 0); } while (0)
#define G2_LDQ(F) do { _Pragma("unroll") for (int k2 = 0; k2 < 2; ++k2) _Pragma("unroll") for (int tt = 0; tt < 4; ++tt) F[k2 * 4 + tt] = *(const bf16x8*)(Bl + 49152 + ((tt * 2 + k2) * 64) * 16); } while (0)
#define G2_MMQ(F) do { _Pragma("unroll") for (int k2 = 0; k2 < 2; ++k2) _Pragma("unroll") for (int tt = 0; tt < 4; ++tt) accC[tt] = __builtin_amdgcn_mfma_f32_16x16x32_bf16(F[k2 * 4 + tt], vf[k2], accC[tt], 0, 0, 0); } while (0)
                G2_LD1(fA, 0); G2_SCHED;
                G2_LD1(fB, 1); G2_SCHED; G2_MM1(fA, 0); G2_SCHED;
                G2_LD1(fA, 2); G2_SCHED; G2_MM1(fB, 1); G2_SCHED;
                G2_LD1(fB, 3); G2_SCHED; G2_MM1(fA, 2); G2_SCHED;
                G2_LDK(fA, 0); G2_SCHED; G2_MM1(fB, 3); G2_SCHED;
                f32x4 vn[4];
#pragma unroll
                for (int tt = 0; tt < 4; ++tt) vn[tt] = (f32x4){lo16(UC_[tt].x), hi16(UC_[tt].x), lo16(UC_[tt].y), hi16(UC_[tt].y)} - accA[tt];
                bf16x8 vf[2];
#pragma unroll
                for (int k2 = 0; k2 < 2; ++k2) { const u32x4 w = pg8::pk8(vn[2 * k2], vn[2 * k2 + 1]); vf[k2] = __builtin_bit_cast(bf16x8, w); }
#pragma unroll
                for (int dt = 0; dt < 8; ++dt) S[dt] = S[dt] * eg;
                G2_SCHED;
                G2_LDK(fB, 1); G2_SCHED; G2_MMK(fA, 0); G2_SCHED;
                G2_LDQ(fA);    G2_SCHED; G2_MMK(fB, 1); G2_SCHED;
                G2_MMQ(fA); G2_SCHED;
#undef G2_SCHED
#undef G2_LD1
#undef G2_MM1
#undef G2_LDK
#undef G2_MMK
#undef G2_LDQ
#undef G2_MMQ
#pragma unroll
                for (int tt = 0; tt < 4; ++tt) {
                    const unsigned w01 = pk2(accC[tt][0], accC[tt][1]), w23 = pk2(accC[tt][2], accC[tt][3]);
                    bf16* op = ORAW + (size_t)((b * 32 + N_) * 64 + 16 * tt + 4 * g) * 1024 + h * 128 + 16 * et + i16;
                    op[0] = (bf16)(w01 & 0xffffu); op[1024] = (bf16)(w01 >> 16); op[2048] = (bf16)(w23 & 0xffffu); op[3072] = (bf16)(w23 >> 16);
                }
            }

            if (N_ + 1 < 32) G2_LOADU(uA, N_ + 1);
            asm volatile("s_waitcnt vmcnt(0)" ::: "memory");
            __syncthreads();
        }
    }
#undef G2_SRC
#undef G2_DMA
#undef G2_LOADU
}

template <bool dry> __device__ __forceinline__ void attn_unit(const Args& a, unsigned char* lds, int b, int h, int qb, int tid, int lane, int wave, float lam) {
    unsigned char* ws = a.ws;
    const bf16* DQ = (const bf16*)(ws + WS_DQ); const bf16* DK = (const bf16*)(ws + WS_DK); const bf16* DVT = (const bf16*)(ws + WS_DVT);
    const int i16 = lane & 15, g = lane >> 4;
    const int q0 = qb * 128 + wave * 16, qpos = q0 + i16;
    const size_t row = (size_t)b * SEQ + qpos;
    bf16x8 qf[2][2];
#pragma unroll
    for (int c = 0; c < 2; ++c)
#pragma unroll
        for (int ks = 0; ks < 2; ++ks) qf[c][ks] = *(const bf16x8*)(DQ + row * 1024 + h * 128 + c * 64 + ks * 32 + g * 8);
    f32x4 O[2][8];
#pragma unroll
    for (int c = 0; c < 2; ++c)
#pragma unroll
        for (int dt = 0; dt < 8; ++dt) O[c][dt] = (f32x4){0.f, 0.f, 0.f, 0.f};
    float mrun[2] = {-1e30f, -1e30f}, lrun[2] = {0.f, 0.f};
    const int nkt = 2 * qb + 2;
    const int rd0 = (g * 16 + (i16 ^ (2 * g))) * 16, rd1 = (g * 16 + (i16 ^ (2 * g) ^ 1)) * 16;
    const bf16* psrc[4]; size_t pstep; int pdst[4];
    {
        const int gl = lane >> 4, xl = lane & 15;
#pragma unroll
        for (int j = 0; j < 4; ++j) {
            const int f = (wave & 3) * 4 + j, par = f & 1, il = xl ^ (2 * gl) ^ par;
            if (wave < 4) { const int c = (f >> 1) & 1, it = f >> 2, key = 32 * (it >> 1) + 8 * (il >> 2) + 4 * (it & 1) + (il & 3);
                psrc[j] = DK + ((size_t)b * SEQ + key) * 1024 + h * 128 + c * 64 + par * 32 + gl * 8; pdst[j] = f * 1024; }
            else { const int dt = f >> 1, d = 16 * dt + il;
                psrc[j] = DVT + (size_t)(h * 128 + d) * M + (size_t)b * SEQ + 32 * par + 8 * gl; pdst[j] = 16384 + f * 1024; }
        }
        pstep = wave < 4 ? (size_t)64 * 1024 : (size_t)64;
    }
#define ATT_DMA(T) do { LAS unsigned char* nb_ = (LAS unsigned char*)lds + ((T) & 1) * 32768; const size_t o_ = (size_t)(T) * pstep; \
        _Pragma("unroll") for (int j = 0; j < 4; ++j) __builtin_amdgcn_global_load_lds((const unsigned*)(psrc[j] + o_), (LAS unsigned*)(nb_ + pdst[j]), 16, 0, 0); } while (0)
    ATT_DMA(0);
    asm volatile("s_waitcnt vmcnt(0)" ::: "memory");
    __syncthreads();
    for (int kt = 0; kt < nkt; ++kt) {
        const bool more = (kt + 1 < nkt);
        if (more) ATT_DMA(kt + 1);
        if (kt * 64 <= q0 + 15) {
            const unsigned char* Kb = lds + (kt & 1) * 32768; const unsigned char* Vb = Kb + 16384;
            const bool need_mask = (kt * 64 + 63 > q0);
            bf16x8 fA[4], fB[4], pf[2][2];
            f32x4 st[4];
#define AT_SCHED __builtin_amdgcn_sched_barrier(0)
#define AT_LDK(F, c, ih) do { _Pragma("unroll") for (int i2 = 0; i2 < 2; ++i2) _Pragma("unroll") for (int ks = 0; ks < 2; ++ks) F[i2 * 2 + ks] = *(const bf16x8*)(Kb + ((((2 * (ih) + i2) * 2 + (c)) * 2 + ks) * 64) * 16 + (ks ? rd1 : rd0)); } while (0)
#define AT_LDV(F, sx, dh) do { _Pragma("unroll") for (int d2 = 0; d2 < 4; ++d2) F[d2] = *(const bf16x8*)(Vb + (((4 * (dh) + d2) * 2 + (sx)) * 64) * 16 + ((sx) ? rd1 : rd0)); } while (0)
#define AT_QK(F, c, ih) do { _Pragma("unroll") for (int i2 = 0; i2 < 2; ++i2) st[2 * (ih) + i2] = (f32x4){0.f, 0.f, 0.f, 0.f}; _Pragma("unroll") for (int ks = 0; ks < 2; ++ks) _Pragma("unroll") for (int i2 = 0; i2 < 2; ++i2) st[2 * (ih) + i2] = __builtin_amdgcn_mfma_f32_16x16x32_bf16(F[i2 * 2 + ks], qf[c][ks], st[2 * (ih) + i2], 0, 0, 0); } while (0)
#define AT_PV(F, sx, dh) do { _Pragma("unroll") for (int d2 = 0; d2 < 4; ++d2) { O[0][4 * (dh) + d2] = __builtin_amdgcn_mfma_f32_16x16x32_bf16(F[d2], pf[0][sx], O[0][4 * (dh) + d2], 0, 0, 0); O[1][4 * (dh) + d2] = __builtin_amdgcn_mfma_f32_16x16x32_bf16(F[d2], pf[1][sx], O[1][4 * (dh) + d2], 0, 0, 0); } } while (0)
#define AT_SOFTMAX(c) do { \
                float mx = -1e30f; \
                _Pragma("unroll") for (int it = 0; it < 4; ++it) _Pragma("unroll") for (int r = 0; r < 4; ++r) { float v = st[it][r]; \
                    if (need_mask) { const int key = kt * 64 + 32 * (it >> 1) + 8 * g + 4 * (it & 1) + r; if (key > qpos) v = -1e30f; } \
                    st[it][r] = v; mx = fmaxf(mx, v); } \
                mx = fmaxf(mx, __shfl_xor(mx, 16)); mx = fmaxf(mx, __shfl_xor(mx, 32)); \
                const float mn = fmaxf(mrun[c], mx), al = __builtin_amdgcn_exp2f(mrun[c] - mn); \
                mrun[c] = mn; \
                float psum = 0.f; \
                _Pragma("unroll") for (int it = 0; it < 4; ++it) _Pragma("unroll") for (int r = 0; r < 4; ++r) { const float pp = __builtin_amdgcn_exp2f(st[it][r] - mn); psum += pp; st[it][r] = pp; } \
                lrun[c] = lrun[c] * al + psum; \
                if (__builtin_amdgcn_ballot_w64(al != 1.0f)) { _Pragma("unroll") for (int dt = 0; dt < 8; ++dt) O[c][dt] = O[c][dt] * al; } \
                _Pragma("unroll") for (int sx = 0; sx < 2; ++sx) { const u32x4 w = pg8::pk8(st[2 * sx], st[2 * sx + 1]); pf[c][sx] = __builtin_bit_cast(bf16x8, w); } \
            } while (0)
            AT_LDK(fA, 0, 0); AT_SCHED;
            AT_LDK(fB, 0, 1); AT_SCHED; AT_QK(fA, 0, 0); AT_SCHED;
            AT_LDK(fA, 1, 0); AT_SCHED; AT_QK(fB, 0, 1); AT_SCHED;
            AT_SOFTMAX(0); AT_SCHED;
            AT_LDK(fB, 1, 1); AT_SCHED; AT_QK(fA, 1, 0); AT_SCHED;
            AT_LDV(fA, 0, 0); AT_SCHED; AT_QK(fB, 1, 1); AT_SCHED;
            AT_SOFTMAX(1); AT_SCHED;
            AT_LDV(fB, 0, 1); AT_SCHED; AT_PV(fA, 0, 0); AT_SCHED;
            AT_LDV(fA, 1, 0); AT_SCHED; AT_PV(fB, 0, 1); AT_SCHED;
            AT_LDV(fB, 1, 1); AT_SCHED; AT_PV(fA, 1, 0); AT_SCHED;
            AT_PV(fB, 1, 1); AT_SCHED;
#undef AT_SCHED
#undef AT_LDK
#undef AT_LDV
#undef AT_QK
#undef AT_PV
#undef AT_SOFTMAX
        }
        asm volatile("s_waitcnt vmcnt(0)" ::: "memory");
        __syncthreads();
    }
#undef ATT_DMA
    float l0 = lrun[0], l1 = lrun[1];
    l0 += __shfl_xor(l0, 16); l0 += __shfl_xor(l0, 32); l1 += __shfl_xor(l1, 16); l1 += __shfl_xor(l1, 32);
    const float il0 = __builtin_amdgcn_rcpf(l0), il1 = lam * __builtin_amdgcn_rcpf(l1);
    const bf16* ORAW = (const bf16*)a.out + (size_t)M * DM;
    bf16* GZ = (bf16*)(ws + WS_GZ); const bf16* GA = (const bf16*)(ws + WS_GA); const bf16* GB = (const bf16*)(ws + WS_GB);
    float ssb = 0.f, ssa = 0.f;
    u32x2 oaw[8];
#pragma unroll
    for (int dt = 0; dt < 8; ++dt) {
        O[0][dt] = O[0][dt] * il0 - O[1][dt] * il1;
        ssb += (O[0][dt][0] * O[0][dt][0] + O[0][dt][1] * O[0][dt][1]) + (O[0][dt][2] * O[0][dt][2] + O[0][dt][3] * O[0][dt][3]);
        oaw[dt] = *(const u32x2*)(ORAW + row * 1024 + h * 128 + dt * 16 + g * 4);
        const float o0 = lo16(oaw[dt].x), o1 = hi16(oaw[dt].x), o2 = lo16(oaw[dt].y), o3 = hi16(oaw[dt].y);
        ssa += (o0 * o0 + o1 * o1) + (o2 * o2 + o3 * o3);
    }
    ssb += __shfl_xor(ssb, 16); ssb += __shfl_xor(ssb, 32); ssa += __shfl_xor(ssa, 16); ssa += __shfl_xor(ssa, 32);
    const float rb = __builtin_amdgcn_rsqf(ssb * (1.0f / 128.0f) + EPS) * (1.0f - LAMBDA_INIT), ra = __builtin_amdgcn_rsqf(ssa * (1.0f / 128.0f) + EPS);
#pragma unroll
    for (int dt = 0; dt < 8; ++dt) {
        const int d0 = dt * 16 + g * 4; const size_t off = row * 1024 + h * 128 + d0;
        const u32x2 zw = *(const u32x2*)(GZ + off), gaw = *(const u32x2*)(GA + off), gbw = *(const u32x2*)(GB + off);
        const f32x4 wsub = *(const f32x4*)(a.in[13] + d0), wgdn = *(const f32x4*)(a.in[6] + d0);
        const float zz[4] = {lo16(zw.x), hi16(zw.x), lo16(zw.y), hi16(zw.y)}, ga[4] = {lo16(gaw.x), hi16(gaw.x), lo16(gaw.y), hi16(gaw.y)}, gb[4] = {lo16(gbw.x), hi16(gbw.x), lo16(gbw.y), hi16(gbw.y)};
        const float oa[4] = {lo16(oaw[dt].x), hi16(oaw[dt].x), lo16(oaw[dt].y), hi16(oaw[dt].y)};
        float mv[4];
#pragma unroll
        for (int r = 0; r < 4; ++r) mv[r] = sigmoidf_(ga[r]) * (oa[r] * ra * wgdn[r] * siluf_(zz[r])) + sigmoidf_(gb[r]) * (O[0][dt][r] * rb * wsub[r]);
        u32x2 w; w.x = pk2(mv[0], mv[1]); w.y = pk2(mv[2], mv[3]);
        if (!dry) *(u32x2*)(GZ + off) = w;
    }
}

typedef __attribute__((address_space(1))) unsigned gu32;
#define RLX_AGENT __ATOMIC_RELAXED, __HIP_MEMORY_SCOPE_AGENT
#define XB_TMO      128
#define XB_XCNT(j)  (256  + 64 * (j))
#define XB_XSUB(j)  (1280 + 64 * (j))
#define XB_XGEN(j)  (2304 + 64 * (j))
#define XB_TOP      3328
#define XB_TOPGEN   3392
#define XCD_BAR_WORDS 3456
#define XB_SPIN_CAP (1u << 18)

__device__ __forceinline__ unsigned xb_ld(unsigned* p)              { return __hip_atomic_load(p, __ATOMIC_RELAXED, __HIP_MEMORY_SCOPE_AGENT); }
__device__ __forceinline__ unsigned xb_add(unsigned* p, unsigned v) { return __hip_atomic_fetch_add(p, v, __ATOMIC_RELAXED, __HIP_MEMORY_SCOPE_AGENT); }
__device__ __forceinline__ unsigned xb_xcc_id() { return (unsigned)__builtin_amdgcn_s_getreg((3 << 11) | 20) & 0xFu; }
#define XB_SPIN(cond, bar) do { unsigned _sp = 0; while (cond) { __builtin_amdgcn_s_sleep(1); \
    if ((++_sp & 255u) == 0u) { if (xb_ld(&(bar)[XB_TMO])) break; if (_sp > XB_SPIN_CAP) { atomicAdd(&(bar)[XB_TMO], 1u); break; } } } } while (0)

struct XcdBarrier {
    unsigned* bar; unsigned x;
    volatile LAS unsigned* st;
};

__device__ __forceinline__ XcdBarrier xcd_barrier_post(unsigned* bar, volatile LAS unsigned* st) {
    XcdBarrier b; b.bar = bar; b.x = xb_xcc_id(); b.st = st;
    if (threadIdx.x == 0) (void)xb_add(&bar[XB_XCNT(b.x)], 1u);
    return b;
}
__device__ __forceinline__ void xcd_barrier_complete(unsigned* bar, unsigned x, unsigned& nloc, unsigned& nx) {
    const unsigned G = gridDim.x * gridDim.y * gridDim.z;
    unsigned sum, cnt, mine, sp = 0u;
    for (;;) {
        sum = 0u; cnt = 0u; mine = 0u;
#pragma unroll
        for (unsigned j = 0; j < 16; ++j) { const unsigned c = xb_ld(&bar[XB_XCNT(j)]); sum += c; cnt += (c > 0u) ? 1u : 0u; mine = (j == x) ? c : mine; }
        if (sum == G) break;
        __builtin_amdgcn_s_sleep(1);
        if ((++sp & 255u) == 0u) { if (xb_ld(&bar[XB_TMO])) break; if (sp > XB_SPIN_CAP) { atomicAdd(&bar[XB_TMO], 1u); break; } }
    }
    nloc = mine > 0u ? mine : 1u; nx = cnt > 0u ? cnt : 1u;
}

__device__ __forceinline__ void xcd_barrier(const XcdBarrier& b, int wave_s) {
    asm volatile("s_waitcnt vmcnt(0)" ::: "memory");
    __syncthreads();
    if (wave_s == 0 && __builtin_amdgcn_mbcnt_hi(~0u, __builtin_amdgcn_mbcnt_lo(~0u, 0u)) == 0u) {
        unsigned* bar = b.bar;
        __builtin_amdgcn_s_waitcnt(0);
        unsigned nloc = b.st[0], nx = b.st[1];
        if (nloc == 0u) { xcd_barrier_complete(bar, b.x, nloc, nx); b.st[0] = nloc; b.st[1] = nx; }
        const unsigned old = xb_add(&bar[XB_XSUB(b.x)], 1u);
        const unsigned gen = old / nloc;
        if (old + 1u == (gen + 1u) * nloc) {
            __builtin_amdgcn_fence(__ATOMIC_RELEASE, "agent");
            asm volatile("s_waitcnt vmcnt(0)" ::: "memory");
            const unsigned og = xb_add(&bar[XB_TOP], 1u);
            const unsigned tg = og / nx;
            if (og + 1u == (tg + 1u) * nx) xb_add(&bar[XB_TOPGEN], 1u);
            else XB_SPIN(xb_ld(&bar[XB_TOPGEN]) == tg, bar);
            __builtin_amdgcn_fence(__ATOMIC_ACQUIRE, "agent");
            xb_add(&bar[XB_XGEN(b.x)], 1u);
            asm volatile("s_waitcnt vmcnt(0)" ::: "memory");
        } else {
            XB_SPIN(xb_ld(&bar[XB_XGEN(b.x)]) == gen, bar);
            __builtin_amdgcn_fence(__ATOMIC_ACQUIRE, "agent");
            asm volatile("s_waitcnt vmcnt(0)" ::: "memory");
        }
    }
    __syncthreads();
}


__global__ void __launch_bounds__(512, 2) fwd_kernel(Args a) {
    extern __shared__ __attribute__((aligned(16))) unsigned char lds[];
    cg::grid_group grid = cg::this_grid();
    const int G = gridDim.x, bx = blockIdx.x;
    volatile LAS unsigned* bst = (volatile LAS unsigned*)((LAS unsigned char*)lds + (LDS_BYTES - 64));
    if (threadIdx.x < 2) bst[threadIdx.x] = 0u;
    __syncthreads();
    const XcdBarrier gbar = xcd_barrier_post((unsigned*)a.ws, bst);
    if (a.ph_hi == 0x7fffffff) grid.sync();
    const int wave_s = __builtin_amdgcn_readfirstlane((int)threadIdx.x >> 6);
#define PHASE_IDS int tid = wave_s * 64 + (int)__builtin_amdgcn_mbcnt_hi(~0u, __builtin_amdgcn_mbcnt_lo(~0u, 0u)); asm volatile("" : "+v"(tid)); const int lane = tid & 63, wave = __builtin_amdgcn_readfirstlane(tid >> 6); (void)lane; (void)wave;
    const int vcu = (G % 8 == 0) ? (bx % 8) * (G / 8) + bx / 8 : bx;
    unsigned char* ws = a.ws;
    LAS unsigned char* ldsl = (LAS unsigned char*)lds;
    const int lo = a.ph_lo, hi = a.ph_hi;
#define IN(k) (lo <= (k) && (k) < hi)
#define SEAM(k) do { if (IN(k) && IN((k) + 1)) xcd_barrier(gbar, wave_s); } while (0)
    bf16* XN = (bf16*)a.out;
    bf16* WIN = (bf16*)(ws + WS_WIN);

    _Pragma("unroll") for (int rp = 0; rp < REP_P0; ++rp) { if (rp) xcd_barrier(gbar, wave_s); if (IN(0)) { PHASE_IDS p0_prologue(a, lds, tid, lane, wave, vcu, G); } }
    SEAM(0);
    _Pragma("unroll") for (int rp = 0; rp < REP_P1G1; ++rp) {
    if (rp) xcd_barrier(gbar, wave_s);
    _Pragma("unroll") for (int rp1 = 0; rp1 < REP_P1; ++rp1) {
    if (rp1) xcd_barrier(gbar, wave_s);
    if (IN(1)) {
        pg8::Gemm g{XN, WIN, M, 3072, 1024}; pg8::StaticOrder S; S.init(M, 3072, G, bx);
        pg8::EpiProj E{(bf16*)(ws + WS_TQ), (bf16*)(ws + WS_TK), (bf16*)(ws + WS_TV), nullptr, nullptr, 7u, (bf16*)(ws + WS_HALO), 0u, nullptr, nullptr, 0};
        pg8::gemm_phase<pg8::EpiProj, pg8::StaticOrder, true, true>(ldsl, g, S, E, wave_s);
    }
    }
    SEAM(1);
    if (IN(2)) { PHASE_IDS u32x4 raw[11]; if (bx < 2048) g1_load_raw(a, bx, tid, raw);
        for (int it = bx; it < 2048; it += G) g1_item(a, lds, it, (it + G < 2048) ? it + G : -1, raw, tid, lane, wave); }
    }
    SEAM(2);
    _Pragma("unroll") for (int rp = 0; rp < REP_G2; ++rp) { if (rp) xcd_barrier(gbar, wave_s); if (IN(3)) { PHASE_IDS for (int it = bx; it < 256; it += G) { const int it2 = (G == 256) ? (((it & 7) * 8 + (it >> 5)) * 4 + ((it >> 3) & 3)) : it;
            g2_item(a, lds, it2, tid, lane, wave); } } }
    SEAM(3);
    _Pragma("unroll") for (int rp = 0; rp < REP_P4; ++rp) {
    if (rp) xcd_barrier(gbar, wave_s);
    if (IN(4)) {
        { pg8::Gemm g{XN, WIN + (size_t)3072 * 1024, M, 5120, 1024}; pg8::StaticOrder S; S.init(M, 5120, G, bx);
          pg8::EpiProj E{(bf16*)(ws + WS_GZ), (bf16*)(ws + WS_GA), (bf16*)(ws + WS_DQ), (bf16*)(ws + WS_DK), (bf16*)(ws + WS_GB), 0u, nullptr, 12u, a.in[7], a.in[8], 2};
          pg8::gemm_phase<pg8::EpiProj, pg8::StaticOrder, true, true>(ldsl, g, S, E, wave_s); }
        { pg8::Gemm g{WIN + (size_t)8192 * 1024, XN, 1024, M, 1024}; pg8::StaticOrder S; S.init(1024, M, G, bx);
          pg8::EpiPlain E{(bf16*)(ws + WS_DVT), M};
          pg8::gemm_phase<pg8::EpiPlain, pg8::StaticOrder, true, true>(ldsl, g, S, E, wave_s); }
    }
    }
    SEAM(4);
    if (IN(5)) {
        PHASE_IDS
        float s1 = 0.f, s2 = 0.f;
        for (int d = 0; d < 64; ++d) { s1 += a.in[9][d] * a.in[10][d]; s2 += a.in[11][d] * a.in[12][d]; }
        const float lam = expf(s1) - expf(s2) + LAMBDA_INIT;
#if REP_ATT > 1
        for (int rp = 1; rp < REP_ATT; ++rp) {
            for (int p = bx; p < 512; p += G) { const int bh = p >> 3, j = p & 7; attn_unit<true>(a, lds, bh >> 3, bh & 7, 15 - j, tid, lane, wave, lam); attn_unit<true>(a, lds, bh >> 3, bh & 7, j, tid, lane, wave, lam); }
            xcd_barrier(gbar, wave_s);
        }
#endif
        for (int p0 = bx; p0 < 512; p0 += G) { const int p = (G == 256) ? ((((p0 & 7) * 8 + ((p0 >> 6) & 3) + 4 * (p0 >> 8)) << 3) | ((p0 >> 3) & 7)) : p0;
            const int bh = p >> 3, j = p & 7; attn_unit<false>(a, lds, bh >> 3, bh & 7, 15 - j, tid, lane, wave, lam); attn_unit<false>(a, lds, bh >> 3, bh & 7, j, tid, lane, wave, lam); }
    }
    SEAM(5);
    _Pragma("unroll") for (int rs = 0; rs < REP_SYNC; ++rs) xcd_barrier(gbar, wave_s);
    _Pragma("unroll") for (int rp6 = 0; rp6 < REP_P6; ++rp6) {
    if (rp6) xcd_barrier(gbar, wave_s);
    if (IN(6)) {
        pg8::Gemm g{(bf16*)(ws + WS_GZ), (bf16*)(ws + WS_WOUT), M, 1024, 1024}; pg8::StaticOrder S; S.init(M, 1024, G, bx);
        pg8::EpiOut E{a.in[0], a.out, (bf16*)(ws + WS_H1B), (float*)(ws + WS_RSS)};
        pg8::gemm_phase<pg8::EpiOut, pg8::StaticOrder, true, true>(ldsl, g, S, E, wave_s);
    }
    }
    SEAM(6);
    _Pragma("unroll") for (int rp = 0; rp < REP_P7; ++rp) {
    if (rp) xcd_barrier(gbar, wave_s);
    if (IN(7)) {
        pg8::Gemm g{(bf16*)(ws + WS_H1B), (bf16*)(ws + WS_WGU), M, 2 * FF, 1024}; pg8::StaticOrder S; S.init(M, 2 * FF, G, bx);
        pg8::EpiSwiGLU E{(const float*)(ws + WS_RSS), (bf16*)(ws + WS_HFF), FF};
        pg8::gemm_phase<pg8::EpiSwiGLU, pg8::StaticOrder, true, true>(ldsl, g, S, E, wave_s);
    }
    }
    SEAM(7);
    _Pragma("unroll") for (int rp8 = 0; rp8 < REP_P8; ++rp8) {
    if (rp8) xcd_barrier(gbar, wave_s);
    if (IN(8)) {
        pg8::Gemm g{(bf16*)(ws + WS_HFF), (bf16*)(ws + WS_WD), M, 1024, FF}; pg8::StaticOrder S; S.init(M, 1024, G, bx);
        pg8::EpiDown E{a.out, (rp8 + 1 < REP_P8) ? (float)a.ph_lo : 1.0f, (const bf16*)(ws + WS_H1B)};
        pg8::gemm_phase<pg8::EpiDown, pg8::StaticOrder, true, true>(ldsl, g, S, E, wave_s);
    }
    }
#undef IN
#undef SEAM
}

extern "C" void kernel_launch(void* const* d_in, const int* in_sizes, int n_in, void* d_out, int out_size, void* d_ws, size_t ws_size, hipStream_t stream) {
    static int grid = 0;
    if (grid == 0) {
        if (n_in != 19 || out_size != M * DM || ws_size < WS_NEED) { fprintf(stderr, "kernel_launch: unexpected problem shape (n_in %d out %d ws %zu)\n", n_in, out_size, ws_size); grid = -1; return; }
        int dev = 0, cus = 0, per_cu = 0;
        hipGetDevice(&dev); hipDeviceGetAttribute(&cus, hipDeviceAttributeMultiprocessorCount, dev);
        hipFuncSetAttribute((const void*)fwd_kernel, hipFuncAttributeMaxDynamicSharedMemorySize, LDS_BYTES);
        hipOccupancyMaxActiveBlocksPerMultiprocessor(&per_cu, (const void*)fwd_kernel, 512, LDS_BYTES);
        if (per_cu < 1) per_cu = 1;
        grid = cus * per_cu;
        (void)hipGetLastError();
    }
    if (grid < 0) return;
    if (hipMemsetAsync(d_ws, 0, 65536, stream) != hipSuccess) { fprintf(stderr, "kernel_launch: memset of the barrier words failed\n"); return; }
    Args a{};
    for (int i = 0; i < 19; ++i) a.in[i] = (const float*)d_in[i];
    a.out = (float*)d_out; a.ws = (unsigned char*)d_ws; a.ph_lo = 0; a.ph_hi = 9;
    void* args[] = {&a};
    hipError_t e = hipLaunchCooperativeKernel((const void*)fwd_kernel, dim3(grid), dim3(512), args, LDS_BYTES, stream);
    if (e != hipSuccess) fprintf(stderr, "cooperative launch failed: %s (grid %d)\n", hipGetErrorString(e), grid);
}
```
